# Optimizing an MI355X kernel written in HIP

```python
import jax, jax.numpy as jnp
from jax import lax
import numpy as np

D_MODEL = 1024
BATCH = 8
SEQ = 4096
DEPTH = 2

CHUNK = 64
POOL_WINDOWS = (2, 4, 8, 16)
POOL_GROUP = 64
D_POOL = POOL_GROUP * len(POOL_WINDOWS)
N_HEADS = 8
HEAD_DIM = 64
D_ATTN = N_HEADS * HEAD_DIM
N_PREV_CHUNKS = 8
BAND = (N_PREV_CHUNKS + 1) * CHUNK
REL_CLIP = 128
N_REL = 2 * REL_CLIP + 1
D_CONV = 256
CONV_WIDTH = 31
D_FF = 4 * D_MODEL
N_BRANCH = 3
IN_SIZES = (D_POOL, D_ATTN, D_ATTN, D_ATTN, 2 * D_CONV, N_BRANCH * D_MODEL)
IN_SPLITS = tuple(int(v) for v in np.cumsum(IN_SIZES)[:-1])
D_IN = int(sum(IN_SIZES))
ALPHA = (2.0 * DEPTH) ** 0.25
BETA = (8.0 * DEPTH) ** -0.25
LN_EPS = 1e-5
NEG_INF = -1e30

kernel_name = "hybrid_chunk_causal_pool_attn_conv_block"


def layer_norm(x, g=None, b=None):
    xf = x.astype(jnp.float32)
    mu = jnp.mean(xf, axis=-1, keepdims=True)
    var = jnp.mean(jnp.square(xf - mu), axis=-1, keepdims=True)
    y = (xf - mu) * lax.rsqrt(var + LN_EPS)
    if g is not None:
        y = y * g.astype(jnp.float32) + b.astype(jnp.float32)
    return y.astype(x.dtype)


def pool_mixer(a, w_pool, pool_scale):
    B, S, _ = a.shape
    t = jnp.arange(S)
    outs = []
    for gi, w in enumerate(POOL_WINDOWS):
        xg = a[..., gi * POOL_GROUP:(gi + 1) * POOL_GROUP].astype(jnp.float32)
        cs = jnp.cumsum(xg, axis=1)
        cs_lag = jnp.pad(cs, ((0, 0), (w, 0), (0, 0)))[:, :S]
        count = jnp.minimum(t + 1, w).astype(jnp.float32)[None, :, None]
        outs.append((cs - cs_lag) / count - xg)
    p = jnp.stack(outs, axis=2).astype(a.dtype)
    p = jnp.einsum('bsgc,gcd->bsgd', p, w_pool).reshape(B, S, D_POOL)
    return p * pool_scale


def chunk_attention(q, k, v, rel_bias):
    B, S, _ = q.shape
    nc = S // CHUNK
    q = q.reshape(B, nc, CHUNK, N_HEADS, HEAD_DIM) * (HEAD_DIM ** -0.5)
    pad = ((0, 0), (N_PREV_CHUNKS * CHUNK, 0), (0, 0))
    kc = jnp.pad(k, pad).reshape(B, nc + N_PREV_CHUNKS, CHUNK, N_HEADS, HEAD_DIM)
    vc = jnp.pad(v, pad).reshape(B, nc + N_PREV_CHUNKS, CHUNK, N_HEADS, HEAD_DIM)
    band_idx = jnp.arange(nc)[:, None] + jnp.arange(N_PREV_CHUNKS + 1)[None, :]
    kb = kc[:, band_idx].reshape(B, nc, BAND, N_HEADS, HEAD_DIM)
    vb = vc[:, band_idx].reshape(B, nc, BAND, N_HEADS, HEAD_DIM)
    s = jnp.einsum('bnqhd,bnkhd->bnhqk', q, kb).astype(jnp.float32)
    qi = jnp.arange(CHUNK)[:, None]
    kj = jnp.arange(BAND)[None, :]
    rel = jnp.clip(N_PREV_CHUNKS * CHUNK + qi - kj, -REL_CLIP, REL_CLIP) + REL_CLIP
    bias = rel_bias[:, rel].astype(jnp.float32)
    key_pos = jnp.arange(nc)[:, None] * CHUNK + kj - N_PREV_CHUNKS * CHUNK
    valid = (key_pos >= 0)[None, :, None, None, :]
    s = jnp.where(valid, s + bias[None, None], NEG_INF)
    p = jax.nn.softmax(s, axis=-1).astype(vb.dtype)
    o = jnp.einsum('bnhqk,bnkhd->bnqhd', p, vb)
    return o.reshape(B, S, D_ATTN)


def conv_module(cin, conv_w, conv_b, ln_g, ln_b):
    h = cin[..., :D_CONV] * jax.nn.sigmoid(cin[..., D_CONV:])
    h = jnp.pad(h, ((0, 0), (CONV_WIDTH - 1, 0), (0, 0)))
    h = lax.conv_general_dilated(h, conv_w[:, None, :].astype(h.dtype), window_strides=(1,),
                                 padding='VALID', dimension_numbers=('NWC', 'WIO', 'NWC'),
                                 feature_group_count=D_CONV) + conv_b
    return jax.nn.silu(layer_norm(h, ln_g, ln_b))


def setup_inputs(seed: int = 0) -> dict:
    key = jax.random.key(seed)
    ks = jax.random.split(key, 26)
    L, D = DEPTH, D_MODEL

    def nrm(k, shape, scale):
        return jax.random.normal(k, shape, jnp.float32) * scale

    return {
        'x': nrm(ks[0], (BATCH, SEQ, D), 1.0),
        'c': nrm(ks[1], (BATCH, D), 1.0),
        'w_ada': nrm(ks[2], (L, D, 6 * D), 0.5 * D ** -0.5),
        'b_ada': nrm(ks[3], (L, 6 * D), 0.02),
        'w_in': nrm(ks[4], (L, D, D_IN), D ** -0.5),
        'b_gate': nrm(ks[5], (L, N_BRANCH * D), 0.1),
        'w_pool': nrm(ks[6], (L, len(POOL_WINDOWS), POOL_GROUP, POOL_GROUP), POOL_GROUP ** -0.5),
        'pool_scale': 1.0 + nrm(ks[7], (L, D_POOL), 0.1),
        'rel_bias': nrm(ks[8], (L, N_HEADS, N_REL), 0.1),
        'conv_w': nrm(ks[9], (L, CONV_WIDTH, D_CONV), CONV_WIDTH ** -0.5),
        'conv_b': nrm(ks[10], (L, D_CONV), 0.02),
        'conv_ln_g': 1.0 + nrm(ks[11], (L, D_CONV), 0.05),
        'conv_ln_b': nrm(ks[12], (L, D_CONV), 0.02),
        'w_br_pool': nrm(ks[13], (L, D_POOL, D), BETA * D_POOL ** -0.5),
        'w_br_attn': nrm(ks[14], (L, D_ATTN, D), BETA * D_ATTN ** -0.5),
        'w_br_conv': nrm(ks[15], (L, D_CONV, D), BETA * D_CONV ** -0.5),
        'w_o': nrm(ks[16], (L, D, D), BETA * D ** -0.5),
        'ln_mix_g': 1.0 + nrm(ks[17], (L, D), 0.05),
        'ln_mix_b': nrm(ks[18], (L, D), 0.02),
        'w_ff1': nrm(ks[19], (L, D, D_FF), D ** -0.5),
        'b_ff1': nrm(ks[20], (L, D_FF), 0.02),
        'w_ff2': nrm(ks[21], (L, D_FF, D), BETA * D_FF ** -0.5),
        'b_ff2': nrm(ks[22], (L, D), 0.02),
        'ln_ff_g': 1.0 + nrm(ks[23], (L, D), 0.05),
        'ln_ff_b': nrm(ks[24], (L, D), 0.02),
    }


def reference(x, c, w_ada, b_ada, w_in, b_gate, w_pool, pool_scale, rel_bias, conv_w, conv_b,
              conv_ln_g, conv_ln_b, w_br_pool, w_br_attn, w_br_conv, w_o, ln_mix_g, ln_mix_b,
              w_ff1, b_ff1, w_ff2, b_ff2, ln_ff_g, ln_ff_b):
    B, S, _ = x.shape
    c_act = jax.nn.silu(c)
    for l in range(DEPTH):
        mod = (c_act @ w_ada[l] + b_ada[l])[:, None, :]
        sh_m, sc_m, g_m, sh_f, sc_f, g_f = jnp.split(mod, 6, axis=-1)

        u = layer_norm(x) * (1 + sc_m) + sh_m
        z = u @ w_in[l]
        z_pool, z_q, z_k, z_v, z_conv, z_gate = jnp.split(z, IN_SPLITS, axis=-1)
        y_pool = pool_mixer(z_pool, w_pool[l], pool_scale[l]) @ w_br_pool[l]
        y_attn = chunk_attention(z_q, z_k, z_v, rel_bias[l]) @ w_br_attn[l]
        y_conv = conv_module(z_conv, conv_w[l], conv_b[l], conv_ln_g[l], conv_ln_b[l]) @ w_br_conv[l]
        gates = jax.nn.sigmoid(z_gate + b_gate[l]).reshape(B, S, N_BRANCH, D_MODEL)
        merged = gates[:, :, 0] * y_pool + gates[:, :, 1] * y_attn + gates[:, :, 2] * y_conv
        mix_out = merged @ w_o[l]
        x = layer_norm(ALPHA * x + g_m * mix_out, ln_mix_g[l], ln_mix_b[l])

        u = layer_norm(x) * (1 + sc_f) + sh_f
        h = jnp.square(jax.nn.relu(u @ w_ff1[l] + b_ff1[l]))
        ff_out = h @ w_ff2[l] + b_ff2[l]
        x = layer_norm(ALPHA * x + g_f * ff_out, ln_ff_g[l], ln_ff_b[l])
    return x
```

```cpp
#include <hip/hip_runtime.h>
#include <hip/hip_cooperative_groups.h>
#include <cstdio>
#include <cstdint>
namespace cg = cooperative_groups;

#ifndef MK_ONE_LAUNCH
#define MK_ONE_LAUNCH 1
#endif

#define LAS __attribute__((address_space(3)))
typedef unsigned short bf16_t;
typedef short bf16x8 __attribute__((ext_vector_type(8)));
typedef float f32x4 __attribute__((ext_vector_type(4)));
typedef float f32x16 __attribute__((ext_vector_type(16)));
typedef unsigned u32x4 __attribute__((ext_vector_type(4)));
typedef unsigned u32x2 __attribute__((ext_vector_type(2)));

constexpr int M = 32768, D = 1024, SEQ = 4096, DFF = 4096, DEPTH = 2;
constexpr int ZM_LD = 1792, ZG_LD = 3072;
constexpr int NWIN = 4864;
constexpr float ALPHA = 1.4142135623730951f;
constexpr float LN_EPS = 1e-5f;
constexpr float LOG2E = 1.4426950408889634f;
constexpr float QSCALE = 0.125f * LOG2E;

constexpr size_t MiB = 1u << 20;
constexpr size_t WS_MOD = 1 * MiB;
constexpr size_t WS_W = 2 * MiB, WS_WL = 31 * MiB;
constexpr size_t W_IN = 0, W_V = 9 * MiB + MiB / 2, W_BP = 10 * MiB + MiB / 2, W_BA = 11 * MiB, W_BC = 12 * MiB, W_O = 12 * MiB + MiB / 2, W_1 = 14 * MiB + MiB / 2, W_2 = 22 * MiB + MiB / 2;
constexpr size_t WS_UB = 64 * MiB;
constexpr size_t WS_ZM = 128 * MiB;
constexpr size_t WS_VT = 240 * MiB;
constexpr size_t WS_ZG = 272 * MiB;
constexpr size_t WS_H = 128 * MiB;
constexpr size_t WS_MG = 128 * MiB;
constexpr size_t WS_END = 464 * MiB;

constexpr int LDS_BYTES = 147456;
constexpr int NPH = 2 + 8 * DEPTH;

typedef float f32x2_t __attribute__((ext_vector_type(2))); typedef __bf16 bf16x2_t __attribute__((ext_vector_type(2)));
__device__ __forceinline__ unsigned cvt_pk_bf16(float lo, float hi) { f32x2_t v = {lo, hi}; bf16x2_t b = __builtin_convertvector(v, bf16x2_t); return __builtin_bit_cast(unsigned, b); }
__device__ __forceinline__ float bf_lo(unsigned u) { return __uint_as_float(u << 16); }
__device__ __forceinline__ float bf_hi(unsigned u) { return __uint_as_float(u & 0xffff0000u); }
__device__ __forceinline__ float sigmoid_f(float x) { return __builtin_amdgcn_rcpf(1.f + __builtin_amdgcn_exp2f(-LOG2E * x)); }
__device__ __forceinline__ unsigned f2bf(float f) { unsigned u = __builtin_bit_cast(unsigned, f); return (u + 0x7fffu + ((u >> 16) & 1u)) >> 16; }
__device__ __forceinline__ float wave_sum(float v) {
#pragma unroll
    for (int o = 1; o < 64; o <<= 1) v += __shfl_xor(v, o);
    return v;
}
#define LDS_WAIT() asm volatile("s_waitcnt lgkmcnt(0)" ::: "memory")

namespace pg8 {
constexpr int BM = 256, BK = 64, HALF = 128, HTB = HALF * BK * 2, STAGE_BYTES = 8 * HTB, NXCD = 8, WGM = 8;
__host__ __device__ __forceinline__ int lds_byte(int r, int c) { const int st = (r >> 4) * 2 + (c >> 5), rr = r & 15, cc = c & 31, ob = rr * 64 + cc * 2; return st * 1024 + (ob ^ (((ob >> 9) & 1) << 5)); }
__host__ __device__ __forceinline__ void stage_rc(int b, int& R, int& C) { const int st = b / 1024, sb = b % 1024, swz = sb ^ (((sb >> 9) & 1) << 5); R = (st >> 1) * 16 + swz / 64; C = (st & 1) * 32 + (swz % 64) / 2; }
__host__ __device__ __forceinline__ int perm32(int rho) { const int n = rho >> 4, i = rho & 15; return 8 * (i >> 2) + 4 * n + (i & 3); }

struct Unit { int pm, pn; };
struct Gemm { const bf16_t* A; const bf16_t* Bt; int M, N, K, lda, ldb; };

struct StaticOrder {
    int nM, nN, nwg, G, c;
    __host__ __device__ void init(int M_, int N_, int G_, int c_) { nM = M_ / BM; nN = N_ / BM; nwg = nM * nN; G = G_; c = c_; }
    __host__ __device__ bool next(int i, Unit& u) const {
        const long L = (long)i * G + c; if (L >= nwg) return false;
        int wgid = (int)L; { const int q = nwg / NXCD, r = nwg % NXCD, xcd = wgid % NXCD, off = wgid / NXCD; wgid = (xcd < r ? xcd * (q + 1) : r * (q + 1) + (xcd - r) * q) + off; }
        const int nig = WGM * nN, gid = wgid / nig, fm = gid * WGM, gsz = (nM - fm) < WGM ? (nM - fm) : WGM;
        u.pm = fm + ((wgid % nig) % gsz); u.pn = (wgid % nig) / gsz; return true;
    }
};

typedef f32x4 Acc[2][2][4][2];

template <class Epi>
__device__ __forceinline__ void gemm_phase(LAS unsigned char* lds, const int tid, const Gemm g, const StaticOrder& S, const Epi& E) {
    const int wid = __builtin_amdgcn_readfirstlane(tid >> 6), lane = tid & 63, wr = wid >> 2, wc = wid & 3, fr = lane & 15, fq = lane >> 4;
    const int K = g.K, nt = K / BK;
    unsigned voffA[2], voffB[2];
#pragma unroll
    for (int i = 0; i < 2; ++i) { int R, C; stage_rc(tid * 16 + i * 8192, R, C); const int Rb = Epi::PERM ? ((R & ~31) + perm32(R & 31)) : R;
        voffA[i] = (unsigned)(R * g.lda + C) * 2u; voffB[i] = (unsigned)(Rb * g.ldb + C) * 2u; }
    const size_t kstep = (size_t)(BK * 2);
    const size_t hA = (size_t)HALF * g.lda * 2, hB = (size_t)HALF * g.ldb * 2;
    const size_t tA = 2 * hA, tB = 2 * hB;
    const unsigned ldsw = (unsigned)wid * 1024u;
    const int aoff = lds_byte(wr * 64 + fr, fq * 8), boff = lds_byte(wc * 32 + fr, fq * 8);
#define PG8_SA(b, h) (((b) * 2 + (h)) * HTB)
#define PG8_SB(b, h) ((4 + (b) * 2 + (h)) * HTB)
#define PG8_STAGE(bufoff, gbase, voff) do { _Pragma("unroll") for (int _i = 0; _i < 2; ++_i) \
        __builtin_amdgcn_global_load_lds((const unsigned*)((const char*)(gbase) + (voff)[_i]), (LAS unsigned*)(lds + (bufoff) + ldsw + _i * 8192), 16, 0, 0); } while (0)
#define PG8_LDA(dst, b, h) do { _Pragma("unroll") for (int m = 0; m < 4; ++m) _Pragma("unroll") for (int k = 0; k < 2; ++k) dst[m][k] = *(const LAS bf16x8*)(lds + PG8_SA(b, h) + aoff + m * 2048 + k * 1024); } while (0)
#define PG8_LDB(dst, b, h) do { _Pragma("unroll") for (int n = 0; n < 2; ++n) _Pragma("unroll") for (int k = 0; k < 2; ++k) dst[n][k] = *(const LAS bf16x8*)(lds + PG8_SB(b, h) + boff + n * 2048 + k * 1024); } while (0)
#define PG8_MMA(ai, bj, At, Bt) do { __builtin_amdgcn_s_setprio(1); _Pragma("unroll") for (int m = 0; m < 4; ++m) _Pragma("unroll") for (int n = 0; n < 2; ++n) _Pragma("unroll") for (int k = 0; k < 2; ++k) \
        acc[ai][bj][m][n] = __builtin_amdgcn_mfma_f32_16x16x32_bf16(Bt[n][k], At[m][k], acc[ai][bj][m][n], 0, 0, 0); __builtin_amdgcn_s_setprio(0); } while (0)
#define PG8_WAIT_V(n) asm volatile("s_waitcnt vmcnt(" #n ")" ::: "memory")
#define PG8_WAIT_L(n) asm volatile("s_waitcnt lgkmcnt(" #n ")" ::: "memory")
#define PG8_BAR __builtin_amdgcn_s_barrier()
#define PG8_SCHED __builtin_amdgcn_sched_barrier(0)
    Unit cur, nxt; int ui = 0;
    if (!S.next(0, cur)) return;
    Acc acc;
#pragma unroll
    for (int a = 0; a < 2; ++a)
#pragma unroll
        for (int b = 0; b < 2; ++b)
#pragma unroll
            for (int m = 0; m < 4; ++m)
#pragma unroll
                for (int n = 0; n < 2; ++n) acc[a][b][m][n] = (f32x4){0.f, 0.f, 0.f, 0.f};
    bf16x8 At[4][2], B0[2][2], B1[2][2];
    const char* cA = (const char*)g.A + (size_t)cur.pm * tA; const char* cB = (const char*)g.Bt + (size_t)cur.pn * tB;
    PG8_STAGE(PG8_SB(0, 0), cB, voffB); PG8_STAGE(PG8_SB(0, 1), cB + hB, voffB); PG8_STAGE(PG8_SA(0, 0), cA, voffA); PG8_STAGE(PG8_SA(0, 1), cA + hA, voffA);
    if (wr == 1) PG8_BAR;
    PG8_WAIT_V(2); PG8_BAR;
    PG8_STAGE(PG8_SB(1, 0), cB + kstep, voffB); PG8_STAGE(PG8_SA(1, 0), cA + kstep, voffA); PG8_STAGE(PG8_SB(1, 1), cB + hB + kstep, voffB);
    PG8_WAIT_V(6); PG8_BAR;
    for (;;) {
        const bool has_next = S.next(ui + 1, nxt);
        const char* nA = has_next ? (const char*)g.A + (size_t)nxt.pm * tA : cA; const char* nB = has_next ? (const char*)g.Bt + (size_t)nxt.pn * tB : cB;
        for (int t = 0; t < nt; t += 2) {
            const bool last = (t == nt - 2);
            const char* a1 = cA + (size_t)(t + 1) * kstep;
            const char* a2 = last ? nA : cA + (size_t)(t + 2) * kstep; const char* b2 = last ? nB : cB + (size_t)(t + 2) * kstep;
            const char* a3 = a2 + kstep; const char* b3 = b2 + kstep;
            PG8_LDB(B0, 0, 0); PG8_LDB(B1, 0, 1); PG8_SCHED; PG8_LDA(At, 0, 0); PG8_STAGE(PG8_SA(1, 1), a1 + hA, voffA);
            PG8_WAIT_V(8); PG8_WAIT_L(0); PG8_BAR; PG8_MMA(0, 0, At, B0); PG8_MMA(0, 1, At, B1); PG8_BAR; PG8_SCHED;
            PG8_LDA(At, 0, 1); PG8_STAGE(PG8_SB(0, 0), b2, voffB); PG8_STAGE(PG8_SB(0, 1), b2 + hB, voffB); PG8_STAGE(PG8_SA(0, 0), a2, voffA);
            PG8_WAIT_V(8); PG8_WAIT_L(0); PG8_BAR; PG8_MMA(1, 0, At, B0); PG8_MMA(1, 1, At, B1); PG8_BAR; PG8_SCHED;
            PG8_LDB(B0, 1, 0); PG8_LDB(B1, 1, 1); PG8_SCHED; PG8_LDA(At, 1, 0); PG8_STAGE(PG8_SA(0, 1), a2 + hA, voffA);
            PG8_WAIT_V(8); PG8_WAIT_L(0); PG8_BAR; PG8_MMA(0, 0, At, B0); PG8_MMA(0, 1, At, B1); PG8_BAR; PG8_SCHED;
            PG8_LDA(At, 1, 1); PG8_STAGE(PG8_SB(1, 0), b3, voffB); PG8_STAGE(PG8_SB(1, 1), b3 + hB, voffB); PG8_STAGE(PG8_SA(1, 0), a3, voffA);
            PG8_WAIT_V(8); PG8_WAIT_L(0); PG8_BAR; PG8_MMA(1, 0, At, B0); PG8_MMA(1, 1, At, B1); PG8_BAR; PG8_SCHED;
        }
        if (wr == 0) PG8_BAR;
        E(acc, cur, wr, wc, fr, fq);
        if (!has_next) break;
#pragma unroll
        for (int a = 0; a < 2; ++a)
#pragma unroll
            for (int b = 0; b < 2; ++b)
#pragma unroll
                for (int m = 0; m < 4; ++m)
#pragma unroll
                    for (int n = 0; n < 2; ++n) acc[a][b][m][n] = (f32x4){0.f, 0.f, 0.f, 0.f};
        cur = nxt; cA = nA; cB = nB; ++ui;
        if (wr == 1) PG8_BAR;
    }
    PG8_WAIT_V(0);
    PG8_BAR;
#undef PG8_SA
#undef PG8_SB
#undef PG8_STAGE
#undef PG8_LDA
#undef PG8_LDB
#undef PG8_MMA
#undef PG8_WAIT_V
#undef PG8_WAIT_L
#undef PG8_BAR
#undef PG8_SCHED
}

struct EpiZ {
    static constexpr bool PERM = true;
    bf16_t* zm; bf16_t* zg; const float* bgate;
    __device__ __forceinline__ void operator()(const Acc& acc, const Unit& u, int wr, int wc, int fr, int fq) const {
        const int row0 = u.pm * BM + wr * 64 + fr;
        if (u.pn < 7) {
            const float sc = (u.pn == 1 || u.pn == 2) ? QSCALE : 1.f;
            const int col0 = u.pn * BM + wc * 32 + 8 * fq;
#pragma unroll
            for (int ai = 0; ai < 2; ++ai)
#pragma unroll
                for (int m = 0; m < 4; ++m) { bf16_t* rowp = zm + (size_t)(row0 + ai * HALF + m * 16) * ZM_LD + col0;
#pragma unroll
                    for (int bj = 0; bj < 2; ++bj) { const f32x4 v0 = acc[ai][bj][m][0] * sc, v1 = acc[ai][bj][m][1] * sc;
                        u32x4 w; w.x = cvt_pk_bf16(v0[0], v0[1]); w.y = cvt_pk_bf16(v0[2], v0[3]); w.z = cvt_pk_bf16(v1[0], v1[1]); w.w = cvt_pk_bf16(v1[2], v1[3]);
                        *(u32x4*)(rowp + bj * HALF) = w; } }
        } else {
            const int col0 = (u.pn - 7) * BM + wc * 32 + 8 * fq;
            f32x4 bv[2][2];
#pragma unroll
            for (int bj = 0; bj < 2; ++bj)
#pragma unroll
                for (int n = 0; n < 2; ++n) bv[bj][n] = *(const f32x4*)(bgate + col0 + bj * HALF + 4 * n);
#pragma unroll
            for (int ai = 0; ai < 2; ++ai)
#pragma unroll
                for (int m = 0; m < 4; ++m) { bf16_t* rowp = zg + (size_t)(row0 + ai * HALF + m * 16) * ZG_LD + col0;
#pragma unroll
                    for (int bj = 0; bj < 2; ++bj) { f32x4 v0 = acc[ai][bj][m][0] + bv[bj][0], v1 = acc[ai][bj][m][1] + bv[bj][1];
#pragma unroll
                        for (int e = 0; e < 4; ++e) { v0[e] = sigmoid_f(v0[e]); v1[e] = sigmoid_f(v1[e]); }
                        u32x4 w; w.x = cvt_pk_bf16(v0[0], v0[1]); w.y = cvt_pk_bf16(v0[2], v0[3]); w.z = cvt_pk_bf16(v1[0], v1[1]); w.w = cvt_pk_bf16(v1[2], v1[3]);
                        *(u32x4*)(rowp + bj * HALF) = w; } }
        }
    }
};
template <int ACT> struct EpiBf16 {
    static constexpr bool PERM = true;
    bf16_t* O; int ldc; const float* bias;
    __device__ __forceinline__ void operator()(const Acc& acc, const Unit& u, int wr, int wc, int fr, int fq) const {
        const int row0 = u.pm * BM + wr * 64 + fr, col0 = u.pn * BM + wc * 32 + 8 * fq;
        f32x4 bv[2][2];
#pragma unroll
        for (int bj = 0; bj < 2; ++bj)
#pragma unroll
            for (int n = 0; n < 2; ++n) bv[bj][n] = ACT ? *(const f32x4*)(bias + col0 + bj * HALF + 4 * n) : (f32x4){0.f, 0.f, 0.f, 0.f};
#pragma unroll
        for (int ai = 0; ai < 2; ++ai)
#pragma unroll
            for (int m = 0; m < 4; ++m) { bf16_t* rowp = O + (size_t)(row0 + ai * HALF + m * 16) * ldc + col0;
#pragma unroll
                for (int bj = 0; bj < 2; ++bj) { f32x4 v0 = acc[ai][bj][m][0] + bv[bj][0], v1 = acc[ai][bj][m][1] + bv[bj][1];
                    if (ACT) {
#pragma unroll
                        for (int e = 0; e < 4; ++e) { const float a = fmaxf(v0[e], 0.f), b = fmaxf(v1[e], 0.f); v0[e] = a * a; v1[e] = b * b; } }
                    u32x4 w; w.x = cvt_pk_bf16(v0[0], v0[1]); w.y = cvt_pk_bf16(v0[2], v0[3]); w.z = cvt_pk_bf16(v1[0], v1[1]); w.w = cvt_pk_bf16(v1[2], v1[3]);
                    *(u32x4*)(rowp + bj * HALF) = w; } }
    }
};
struct EpiGate {
    static constexpr bool PERM = true;
    bf16_t* mg; const bf16_t* zg; int first;
    __device__ __forceinline__ void operator()(const Acc& acc, const Unit& u, int wr, int wc, int fr, int fq) const {
        const int row0 = u.pm * BM + wr * 64 + fr, col0 = u.pn * BM + wc * 32 + 8 * fq;
#pragma unroll
        for (int ai = 0; ai < 2; ++ai)
#pragma unroll
            for (int m = 0; m < 4; ++m) { const size_t r = (size_t)(row0 + ai * HALF + m * 16);
#pragma unroll
                for (int bj = 0; bj < 2; ++bj) {
                    const u32x4 gv = *(const u32x4*)(zg + r * ZG_LD + col0 + bj * HALF);
                    bf16_t* mp = mg + r * D + col0 + bj * HALF;
                    u32x4 ov = (u32x4){0u, 0u, 0u, 0u}; if (!first) ov = *(const u32x4*)mp;
                    const f32x4 a0 = acc[ai][bj][m][0], a1 = acc[ai][bj][m][1];
                    u32x4 w;
                    w.x = cvt_pk_bf16(bf_lo(ov.x) + bf_lo(gv.x) * a0[0], bf_hi(ov.x) + bf_hi(gv.x) * a0[1]);
                    w.y = cvt_pk_bf16(bf_lo(ov.y) + bf_lo(gv.y) * a0[2], bf_hi(ov.y) + bf_hi(gv.y) * a0[3]);
                    w.z = cvt_pk_bf16(bf_lo(ov.z) + bf_lo(gv.z) * a1[0], bf_hi(ov.z) + bf_hi(gv.z) * a1[1]);
                    w.w = cvt_pk_bf16(bf_lo(ov.w) + bf_lo(gv.w) * a1[2], bf_hi(ov.w) + bf_hi(gv.w) * a1[3]);
                    *(u32x4*)mp = w; } }
    }
};
struct EpiRes {
    static constexpr bool PERM = false;
    const float* xin; float* out; const float* gvec; const float* bias;
    __device__ __forceinline__ void operator()(const Acc& acc, const Unit& u, int wr, int wc, int fr, int fq) const {
        const int row0 = u.pm * BM + wr * 64 + fr, col0 = u.pn * BM + wc * 32 + 4 * fq;
        const float* gp = gvec + (size_t)(u.pm >> 4) * 6144;
#pragma unroll
        for (int bj = 0; bj < 2; ++bj)
#pragma unroll
            for (int n = 0; n < 2; ++n) { const int col = col0 + bj * HALF + n * 16;
                const f32x4 gv = *(const f32x4*)(gp + col); const f32x4 bv = bias ? *(const f32x4*)(bias + col) : (f32x4){0.f, 0.f, 0.f, 0.f};
#pragma unroll
                for (int ai = 0; ai < 2; ++ai)
#pragma unroll
                    for (int m = 0; m < 4; ++m) { const size_t off = (size_t)(row0 + ai * HALF + m * 16) * D + col;
                        const f32x4 xv = *(const f32x4*)(xin + off);
                        *(f32x4*)(out + off) = xv * ALPHA + gv * (acc[ai][bj][m][n] + bv); } }
    }
};
}

struct Args { const float* in[25]; float* out; unsigned char* ws; int ph_lo, ph_hi; };
enum { I_X = 0, I_C, I_WADA, I_BADA, I_WIN, I_BGATE, I_WPOOL, I_PSCALE, I_RELB, I_CONVW, I_CONVB, I_CLNG, I_CLNB, I_WBP, I_WBA, I_WBC, I_WO, I_LMG, I_LMB, I_W1, I_B1, I_W2, I_B2, I_LFG, I_LFB };

__device__ __forceinline__ void tr_item(const float* W, int N, int k0, int n0, bf16_t* dst, int dK, LAS float* scr, int lane) {
#pragma unroll 8
    for (int i = 0; i < 32; ++i) { const int kk = 2 * i + (lane >> 5); scr[kk * 33 + (lane & 31)] = W[(size_t)(k0 + kk) * N + n0 + (lane & 31)]; }
    LDS_WAIT();
    const int c = lane & 7;
#pragma unroll
    for (int j = 0; j < 4; ++j) { const int n = (lane >> 3) + 8 * j; const LAS float* s = scr + (8 * c) * 33 + n;
        u32x4 o; o.x = f2bf(s[0 * 33]) | (f2bf(s[1 * 33]) << 16); o.y = f2bf(s[2 * 33]) | (f2bf(s[3 * 33]) << 16); o.z = f2bf(s[4 * 33]) | (f2bf(s[5 * 33]) << 16); o.w = f2bf(s[6 * 33]) | (f2bf(s[7 * 33]) << 16);
        *(u32x4*)(dst + (size_t)n * dK + 8 * c) = o; }
    LDS_WAIT();
}

template <int MODE>
__device__ __forceinline__ void ln_pass(const float* src, float* dst, bf16_t* u, const float* g, const float* bb, const float* modsc, const float* modsh, int gw, int ngw, int lane) {
    for (int row0 = gw * 16; row0 < M; row0 += ngw * 16) {
        const int batch = row0 >> 12;
        f32x4 gv[4], bv[4], scv[4], shv[4];
#pragma unroll
        for (int j = 0; j < 4; ++j) {
            if (MODE >= 1) { gv[j] = *(const f32x4*)(g + 4 * lane + 256 * j); bv[j] = *(const f32x4*)(bb + 4 * lane + 256 * j); }
            if (MODE != 2) { scv[j] = *(const f32x4*)(modsc + (size_t)batch * 6144 + 4 * lane + 256 * j) + 1.f; shv[j] = *(const f32x4*)(modsh + (size_t)batch * 6144 + 4 * lane + 256 * j); }
        }
        f32x4 nv[4];
#pragma unroll
        for (int j = 0; j < 4; ++j) nv[j] = *(const f32x4*)(src + (size_t)row0 * D + 4 * lane + 256 * j);
        for (int r = 0; r < 16; ++r) {
            const size_t off = (size_t)(row0 + r) * D + 4 * lane;
            f32x4 v[4];
#pragma unroll
            for (int j = 0; j < 4; ++j) v[j] = nv[j];
            if (r < 15) {
#pragma unroll
                for (int j = 0; j < 4; ++j) nv[j] = *(const f32x4*)(src + off + D + 256 * j);
            }
            float s = 0.f;
#pragma unroll
            for (int j = 0; j < 4; ++j) s += (v[j].x + v[j].y) + (v[j].z + v[j].w);
            float mean = wave_sum(s) * (1.f / D), s2 = 0.f;
#pragma unroll
            for (int j = 0; j < 4; ++j) { v[j] = v[j] - mean; s2 += (v[j].x * v[j].x + v[j].y * v[j].y) + (v[j].z * v[j].z + v[j].w * v[j].w); }
            float rstd = 1.f / sqrtf(wave_sum(s2) * (1.f / D) + LN_EPS);
            if (MODE >= 1) {
                s = 0.f;
#pragma unroll
                for (int j = 0; j < 4; ++j) { v[j] = v[j] * rstd * gv[j] + bv[j]; *(f32x4*)(dst + off + 256 * j) = v[j]; s += (v[j].x + v[j].y) + (v[j].z + v[j].w); }
                if (MODE == 1) {
                    mean = wave_sum(s) * (1.f / D); s2 = 0.f;
#pragma unroll
                    for (int j = 0; j < 4; ++j) { v[j] = v[j] - mean; s2 += (v[j].x * v[j].x + v[j].y * v[j].y) + (v[j].z * v[j].z + v[j].w * v[j].w); }
                    rstd = 1.f / sqrtf(wave_sum(s2) * (1.f / D) + LN_EPS);
                }
            }
            if (MODE != 2) {
#pragma unroll
                for (int j = 0; j < 4; ++j) { const f32x4 o = v[j] * rstd * scv[j] + shv[j]; u32x2 w; w.x = cvt_pk_bf16(o.x, o.y); w.y = cvt_pk_bf16(o.z, o.w); *(u32x2*)(u + off + 256 * j) = w; }
            }
        }
    }
}

__device__ __forceinline__ void attn_wave(const bf16_t* zm, const bf16_t* vt, bf16_t* bcat, const LAS float* rb  , int b, int n, int h, int qh, int lane) {
    const int r32 = lane & 31, hi = lane >> 5;
    const size_t tok0 = (size_t)b * SEQ + (size_t)n * 64;
    const bf16_t* qp = zm + (tok0 + qh * 32 + r32) * ZM_LD + 256 + h * 64 + hi * 8;
    bf16x8 qf[4];
#pragma unroll
    for (int d0 = 0; d0 < 4; ++d0) qf[d0] = *(const bf16x8*)(qp + d0 * 16);
    const int pi = (r32 & ~12) | ((r32 & 4) << 1) | ((r32 & 8) >> 1);
    float m_run = -1e30f, l_run = 0.f;
    f32x16 o[2];
#pragma unroll
    for (int r = 0; r < 16; ++r) { o[0][r] = 0.f; o[1][r] = 0.f; }
    const int qi = qh * 32 + r32;
    const int jlo = n < 8 ? 8 - n : 0;
    for (int j = jlo; j <= 8; ++j) {
        const int delta = 8 - j;
        const size_t kt0 = tok0 - (size_t)delta * 64;
        bf16x8 kf[2][4], vf[2][4];
#pragma unroll
        for (int kb = 0; kb < 2; ++kb) { const bf16_t* kp = zm + (kt0 + kb * 32 + pi) * ZM_LD + 768 + h * 64 + hi * 8;
#pragma unroll
            for (int d0 = 0; d0 < 4; ++d0) kf[kb][d0] = *(const bf16x8*)(kp + d0 * 16); }
#pragma unroll
        for (int db = 0; db < 2; ++db) { const bf16_t* vp = vt + (size_t)(h * 64 + db * 32 + r32) * M + kt0 + hi * 8;
#pragma unroll
            for (int c = 0; c < 4; ++c) vf[db][c] = *(const bf16x8*)(vp + c * 16); }
        f32x16 s[2];
#pragma unroll
        for (int kb = 0; kb < 2; ++kb) {
#pragma unroll
            for (int r = 0; r < 16; ++r) s[kb][r] = 0.f;
#pragma unroll
            for (int d0 = 0; d0 < 4; ++d0) s[kb] = __builtin_amdgcn_mfma_f32_32x32x16_bf16(kf[kb][d0], qf[d0], s[kb], 0, 0, 0);
        }
        if (delta >= 3) {
            const float cb = rb[256];
#pragma unroll
            for (int kb = 0; kb < 2; ++kb)
#pragma unroll
                for (int r = 0; r < 16; ++r) s[kb][r] += cb;
        } else {
            const int base = delta * 64 + qi - 8 * hi;
#pragma unroll
            for (int kb = 0; kb < 2; ++kb)
#pragma unroll
                for (int r = 0; r < 16; ++r) { int dd = base - (kb * 32 + 16 * (r >> 3) + (r & 7)); dd = dd > 128 ? 128 : dd; s[kb][r] += rb[dd + 128]; }
        }
        float mx = s[0][0];
#pragma unroll
        for (int kb = 0; kb < 2; ++kb)
#pragma unroll
            for (int r = 0; r < 16; ++r) mx = fmaxf(mx, s[kb][r]);
        mx = fmaxf(mx, __shfl_xor(mx, 32));
        const float m_new = fmaxf(m_run, mx);
        const float f = __builtin_amdgcn_exp2f(m_run - m_new);
        m_run = m_new;
        float ps = 0.f;
#pragma unroll
        for (int kb = 0; kb < 2; ++kb)
#pragma unroll
            for (int r = 0; r < 16; ++r) { s[kb][r] = __builtin_amdgcn_exp2f(s[kb][r] - m_new); ps += s[kb][r]; }
        l_run = l_run * f + ps;
#pragma unroll
        for (int r = 0; r < 16; ++r) { o[0][r] *= f; o[1][r] *= f; }
        bf16x8 pf[4];
#pragma unroll
        for (int c = 0; c < 4; ++c) { const int kb = c >> 1, s8 = (c & 1) * 8; u32x4 w;
            w.x = cvt_pk_bf16(s[kb][s8 + 0], s[kb][s8 + 1]); w.y = cvt_pk_bf16(s[kb][s8 + 2], s[kb][s8 + 3]); w.z = cvt_pk_bf16(s[kb][s8 + 4], s[kb][s8 + 5]); w.w = cvt_pk_bf16(s[kb][s8 + 6], s[kb][s8 + 7]);
            pf[c] = __builtin_bit_cast(bf16x8, w); }
#pragma unroll
        for (int db = 0; db < 2; ++db)
#pragma unroll
            for (int c = 0; c < 4; ++c) o[db] = __builtin_amdgcn_mfma_f32_32x32x16_bf16(vf[db][c], pf[c], o[db], 0, 0, 0);
    }
    const float l = l_run + __shfl_xor(l_run, 32);
    const float inv = 1.f / l;
    bf16_t* op = bcat + (tok0 + qh * 32 + r32) * D + 256 + h * 64 + 4 * hi;
#pragma unroll
    for (int db = 0; db < 2; ++db)
#pragma unroll
        for (int g4 = 0; g4 < 4; ++g4) { u32x2 w; w.x = cvt_pk_bf16(o[db][4 * g4 + 0] * inv, o[db][4 * g4 + 1] * inv); w.y = cvt_pk_bf16(o[db][4 * g4 + 2] * inv, o[db][4 * g4 + 3] * inv);
            *(u32x2*)(op + db * 32 + 8 * g4) = w; }
}

__device__ __forceinline__ void conv_unit(LAS unsigned char* lds, const bf16_t* zm, bf16_t* bcat, const float* cw, const float* cb, const float* lg, const float* lb, int unit, int tid, int wave, int lane) {
    LAS float* hbuf = (LAS float*)(lds + 16384);
    LAS float* obuf = (LAS float*)(lds + 16384 + 62 * 256 * 4);
    const int b = unit >> 7, t0 = (unit & 127) * 32;
    for (int it = tid; it < 62 * 32; it += 512) {
        const int i = it >> 5, c8 = (it & 31) * 8, t = t0 - 30 + i;
        f32x4 h0 = (f32x4){0.f, 0.f, 0.f, 0.f}, h1 = h0;
        if (t >= 0) {
            const bf16_t* p = zm + ((size_t)b * SEQ + t) * ZM_LD + 1280 + c8;
            const u32x4 av = *(const u32x4*)p, gv = *(const u32x4*)(p + 256);
            h0 = (f32x4){bf_lo(av.x) * sigmoid_f(bf_lo(gv.x)), bf_hi(av.x) * sigmoid_f(bf_hi(gv.x)), bf_lo(av.y) * sigmoid_f(bf_lo(gv.y)), bf_hi(av.y) * sigmoid_f(bf_hi(gv.y))};
            h1 = (f32x4){bf_lo(av.z) * sigmoid_f(bf_lo(gv.z)), bf_hi(av.z) * sigmoid_f(bf_hi(gv.z)), bf_lo(av.w) * sigmoid_f(bf_lo(gv.w)), bf_hi(av.w) * sigmoid_f(bf_hi(gv.w))};
        }
        *(LAS f32x4*)(hbuf + i * 256 + c8) = h0; *(LAS f32x4*)(hbuf + i * 256 + c8 + 4) = h1;
    }
    __syncthreads();
    {
        const int c = tid & 255, th = tid >> 8;
        float w[31];
#pragma unroll
        for (int j = 0; j < 31; ++j) w[j] = cw[j * 256 + c];
        float acc[16]; const float bias = cb[c];
#pragma unroll
        for (int tt = 0; tt < 16; ++tt) acc[tt] = bias;
#pragma unroll
        for (int i = 0; i < 46; ++i) { const float hv = hbuf[(th * 16 + i) * 256 + c];
#pragma unroll
            for (int tt = 0; tt < 16; ++tt) { if (i - tt >= 0 && i - tt <= 30) acc[tt] += hv * w[i - tt]; } }
#pragma unroll
        for (int tt = 0; tt < 16; ++tt) obuf[(th * 16 + tt) * 256 + c] = acc[tt];
    }
    __syncthreads();
    {
        const f32x4 g4 = *(const f32x4*)(lg + 4 * lane), b4 = *(const f32x4*)(lb + 4 * lane);
#pragma unroll
        for (int k = 0; k < 4; ++k) { const int tok = wave * 4 + k;
            f32x4 v = *(const LAS f32x4*)(obuf + tok * 256 + 4 * lane);
            const float mean = wave_sum((v.x + v.y) + (v.z + v.w)) * (1.f / 256.f);
            v = v - mean;
            const float var = wave_sum((v.x * v.x + v.y * v.y) + (v.z * v.z + v.w * v.w)) * (1.f / 256.f);
            const float rstd = 1.f / sqrtf(var + LN_EPS);
            f32x4 y = v * rstd * g4 + b4;
#pragma unroll
            for (int e = 0; e < 4; ++e) y[e] = y[e] * sigmoid_f(y[e]);
            u32x2 wv; wv.x = cvt_pk_bf16(y.x, y.y); wv.y = cvt_pk_bf16(y.z, y.w);
            *(u32x2*)(bcat + ((size_t)b * SEQ + t0 + tok) * D + 768 + 4 * lane) = wv; }
    }
    __syncthreads();
}

__global__ void __launch_bounds__(512, 2) fwd(Args a) {
    extern __shared__ __attribute__((aligned(16))) unsigned char lds_raw[];
    LAS unsigned char* lds = (LAS unsigned char*)lds_raw;
    cg::grid_group grid = cg::this_grid();
    const int ph_lo = a.ph_lo, ph_hi = a.ph_hi;

    for (int ph = ph_lo; ph < ph_hi; ++ph) {
        if (ph > ph_lo) grid.sync();
        const __attribute__((address_space(4))) Args* ap = (const __attribute__((address_space(4))) Args*)__builtin_amdgcn_kernarg_segment_ptr();
        asm volatile("" : "+s"(ap));
        int tid = threadIdx.x; asm volatile("" : "+v"(tid));
        const int lane = tid & 63, wave = __builtin_amdgcn_readfirstlane(tid >> 6);
        const int G = gridDim.x, bx = blockIdx.x;
        const int vcu = (G % 8 == 0) ? (bx % 8) * (G / 8) + bx / 8 : bx;
        const int gw = vcu * 8 + wave, ngw = G * 8;
#define AIN(k) (ap->in[k])
        unsigned char* ws = ap->ws;
        float* mod = (float*)(ws + WS_MOD);
        bf16_t* UB = (bf16_t*)(ws + WS_UB); bf16_t* ZM = (bf16_t*)(ws + WS_ZM); bf16_t* VT = (bf16_t*)(ws + WS_VT); bf16_t* ZG = (bf16_t*)(ws + WS_ZG);
        bf16_t* HB = (bf16_t*)(ws + WS_H); bf16_t* MG = (bf16_t*)(ws + WS_MG);
        float* outp = ap->out;
        if (ph == 0) {
            LAS float* cact = (LAS float*)(lds + 98304);
            for (int i = tid; i < 8 * D; i += 512) { const float cv = AIN(I_C)[i]; cact[i] = cv * sigmoid_f(cv); }
            __syncthreads();
            for (int it = wave * G + bx; it < 192; it += 8 * G) {
                const int l = it / 96, j = (it % 96) * 64 + lane;
                const float* W = AIN(I_WADA) + (size_t)l * D * 6144 + j;
                float acc[8];
#pragma unroll
                for (int b = 0; b < 8; ++b) acc[b] = AIN(I_BADA)[l * 6144 + j];
                for (int k = 0; k < D; k += 8) {
                    float wv[8];
#pragma unroll
                    for (int u = 0; u < 8; ++u) wv[u] = W[(size_t)(k + u) * 6144];
#pragma unroll
                    for (int b = 0; b < 8; ++b) { const f32x4 c0 = *(const LAS f32x4*)(cact + b * D + k), c1 = *(const LAS f32x4*)(cact + b * D + k + 4);
                        acc[b] += (c0.x * wv[0] + c0.y * wv[1]) + (c0.z * wv[2] + c0.w * wv[3]) + (c1.x * wv[4] + c1.y * wv[5]) + (c1.z * wv[6] + c1.w * wv[7]); }
                }
#pragma unroll
                for (int b = 0; b < 8; ++b) mod[(size_t)(l * 8 + b) * 6144 + j] = acc[b];
            }
            LAS float* scr = (LAS float*)(lds + wave * 8704);
            constexpr int PER_L = 7680 + 128;
            for (int it = gw; it < DEPTH * PER_L; it += ngw) {
                const int l = it / PER_L; int r = it % PER_L;
                unsigned char* wl = ws + WS_W + (size_t)l * WS_WL;
                if (r < 2688) { const int k0 = (r / 168) * 64, n0 = (r % 168) * 32;
                    bf16_t* dst = (n0 >= 1280 && n0 < 1792) ? (bf16_t*)(wl + W_V) + (size_t)(n0 - 1280) * D + k0 : (bf16_t*)(wl + W_IN) + (size_t)(n0 >= 1792 ? n0 - 512 : n0) * D + k0;
                    tr_item(AIN(I_WIN) + (size_t)l * D * 5376, 5376, k0, n0, dst, D, scr, lane); continue; } r -= 2688;
                if (r < 256) { const int k0 = (r / 32) * 64, n0 = (r % 32) * 32; tr_item(AIN(I_WBA) + (size_t)l * 512 * D, D, k0, n0, (bf16_t*)(wl + W_BA) + (size_t)n0 * 512 + k0, 512, scr, lane); continue; } r -= 256;
                if (r < 128) { const int k0 = (r / 32) * 64, n0 = (r % 32) * 32; tr_item(AIN(I_WBC) + (size_t)l * 256 * D, D, k0, n0, (bf16_t*)(wl + W_BC) + (size_t)n0 * 256 + k0, 256, scr, lane); continue; } r -= 128;
                if (r < 512) { const int k0 = (r / 32) * 64, n0 = (r % 32) * 32; tr_item(AIN(I_WO) + (size_t)l * D * D, D, k0, n0, (bf16_t*)(wl + W_O) + (size_t)n0 * D + k0, D, scr, lane); continue; } r -= 512;
                if (r < 2048) { const int k0 = (r / 128) * 64, n0 = (r % 128) * 32; tr_item(AIN(I_W1) + (size_t)l * D * DFF, DFF, k0, n0, (bf16_t*)(wl + W_1) + (size_t)n0 * D + k0, D, scr, lane); continue; } r -= 2048;
                if (r < 2048) { const int k0 = (r / 32) * 64, n0 = (r % 32) * 32; tr_item(AIN(I_W2) + (size_t)l * DFF * D, D, k0, n0, (bf16_t*)(wl + W_2) + (size_t)n0 * DFF + k0, DFF, scr, lane); continue; } r -= 2048;
                {
                    const int g = r >> 5, n0 = (r & 31) * 32;
                    const float* ps = AIN(I_PSCALE) + l * 256 + g * 64; const float* wb = AIN(I_WBP) + (size_t)l * 256 * D + (size_t)(g * 64) * D + n0;
#pragma unroll 8
                    for (int i = 0; i < 32; ++i) { const int d = 2 * i + (lane >> 5), n = lane & 31; scr[n * 68 + d] = ps[d] * wb[(size_t)d * D + n]; }
                    LDS_WAIT();
                    f32x4 wpr[16]; const float* wp = AIN(I_WPOOL) + ((size_t)(l * 4 + g) * 64 + lane) * 64;
#pragma unroll
                    for (int q = 0; q < 16; ++q) wpr[q] = *(const f32x4*)(wp + 4 * q);
                    bf16_t* dst = (bf16_t*)(wl + W_BP) + (size_t)n0 * 256 + g * 64 + lane;
                    for (int n = 0; n < 32; ++n) { float acc = 0.f;
#pragma unroll
                        for (int q = 0; q < 16; ++q) { const f32x4 sv = *(const LAS f32x4*)(scr + n * 68 + 4 * q); acc += (wpr[q].x * sv.x + wpr[q].y * sv.y) + (wpr[q].z * sv.z + wpr[q].w * sv.w); }
                        dst[(size_t)n * 256] = (bf16_t)f2bf(acc); }
                    LDS_WAIT();
                }
            }
            __syncthreads();
        } else if (ph == 1) {
            ln_pass<0>(AIN(I_X), nullptr, UB, nullptr, nullptr, mod + 1 * D, mod + 0 * D, gw, ngw, lane);
        } else {
            const int l = (ph - 2) >> 3, sp = (ph - 2) & 7;
            unsigned char* wl = ws + WS_W + (size_t)l * WS_WL;
            const float* modl = mod + (size_t)l * 8 * 6144;
            if (sp == 0) {
                { pg8::Gemm g{UB, (const bf16_t*)(wl + W_IN), M, NWIN, D, D, D}; pg8::StaticOrder S; S.init(M, NWIN, G, bx);
                  pg8::EpiZ E{ZM, ZG, AIN(I_BGATE) + l * 3072};
                  pg8::gemm_phase(lds, tid, g, S, E); }
                { pg8::Gemm g{(const bf16_t*)(wl + W_V), UB, 512, M, D, D, D}; pg8::StaticOrder S; S.init(512, M, G, bx);
                  pg8::EpiBf16<0> E{VT, M, nullptr};
                  pg8::gemm_phase(lds, tid, g, S, E); }
            } else if (sp == 1) {
                LAS float* rbl = (LAS float*)lds;
                for (int i = tid; i < 8 * 257; i += 512) { const int h = i / 257, k = i % 257; rbl[h * 264 + k] = AIN(I_RELB)[(size_t)l * 8 * 257 + i] * LOG2E; }
                __syncthreads();
                for (int unit = vcu; unit < 512; unit += G) { const int b = unit >> 6, n = unit & 63;
                    attn_wave(ZM, VT, UB, rbl + wave * 264, b, n, wave, 0, lane);
                    attn_wave(ZM, VT, UB, rbl + wave * 264, b, n, wave, 1, lane); }
                for (int it = bx * 512 + tid; it < M * 32; it += G * 512) {
                    const int r = it >> 5, c0 = (it & 31) * 8, w = 2 << (c0 >> 6), t = r & (SEQ - 1), cnt = (t + 1) < w ? (t + 1) : w;
                    const bf16_t* p = ZM + (size_t)r * ZM_LD + c0;
                    const u32x4 x0 = *(const u32x4*)p;
                    float x[8] = {bf_lo(x0.x), bf_hi(x0.x), bf_lo(x0.y), bf_hi(x0.y), bf_lo(x0.z), bf_hi(x0.z), bf_lo(x0.w), bf_hi(x0.w)};
                    float s[8];
#pragma unroll
                    for (int e = 0; e < 8; ++e) s[e] = x[e];
                    for (int i = 1; i < cnt; ++i) { const u32x4 v = *(const u32x4*)(p - (size_t)i * ZM_LD);
                        s[0] += bf_lo(v.x); s[1] += bf_hi(v.x); s[2] += bf_lo(v.y); s[3] += bf_hi(v.y); s[4] += bf_lo(v.z); s[5] += bf_hi(v.z); s[6] += bf_lo(v.w); s[7] += bf_hi(v.w); }
                    const float inv = 1.f / (float)cnt;
                    u32x4 o; o.x = cvt_pk_bf16(s[0] * inv - x[0], s[1] * inv - x[1]); o.y = cvt_pk_bf16(s[2] * inv - x[2], s[3] * inv - x[3]);
                    o.z = cvt_pk_bf16(s[4] * inv - x[4], s[5] * inv - x[5]); o.w = cvt_pk_bf16(s[6] * inv - x[6], s[7] * inv - x[7]);
                    *(u32x4*)(UB + (size_t)r * D + c0) = o;
                }
                for (int unit = vcu; unit < 1024; unit += G)
                    conv_unit(lds, ZM, UB, AIN(I_CONVW) + l * 31 * 256, AIN(I_CONVB) + l * 256, AIN(I_CLNG) + l * 256, AIN(I_CLNB) + l * 256, unit, tid, wave, lane);
            } else if (sp == 2) {
                for (int br = 0; br < 3; ++br) {
                    const int K = br == 1 ? 512 : 256, aoff = br == 0 ? 0 : (br == 1 ? 256 : 768);
                    const bf16_t* Bt = (const bf16_t*)(wl + (br == 0 ? W_BP : (br == 1 ? W_BA : W_BC)));
                    pg8::Gemm g{UB + aoff, Bt, M, D, K, D, K}; pg8::StaticOrder S; S.init(M, D, G, bx);
                    pg8::EpiGate E{MG, ZG + br * D, br == 0};
                    pg8::gemm_phase(lds, tid, g, S, E);
                }
            } else if (sp == 3 || sp == 6) {
                const bool ff = (sp == 6);
                pg8::Gemm g{ff ? HB : MG, (const bf16_t*)(wl + (ff ? W_2 : W_O)), M, D, ff ? DFF : D, ff ? DFF : D, ff ? DFF : D}; pg8::StaticOrder S; S.init(M, D, G, bx);
                pg8::EpiRes E{(!ff && l == 0) ? AIN(I_X) : outp, outp, modl + (ff ? 5 : 2) * D, ff ? AIN(I_B2) + l * D : nullptr};
                pg8::gemm_phase(lds, tid, g, S, E);
            } else if (sp == 4) {
                ln_pass<1>(outp, outp, UB, AIN(I_LMG) + l * D, AIN(I_LMB) + l * D, modl + 4 * D, modl + 3 * D, gw, ngw, lane);
            } else if (sp == 5) {
                pg8::Gemm g{UB, (const bf16_t*)(wl + W_1), M, DFF, D, D, D}; pg8::StaticOrder S; S.init(M, DFF, G, bx);
                pg8::EpiBf16<1> E{HB, DFF, AIN(I_B1) + l * DFF};
                pg8::gemm_phase(lds, tid, g, S, E);
            } else {
                if (l + 1 < DEPTH) ln_pass<1>(outp, outp, UB, AIN(I_LFG) + l * D, AIN(I_LFB) + l * D, modl + 8 * 6144 + 1 * D, modl + 8 * 6144 + 0 * D, gw, ngw, lane);
                else ln_pass<2>(outp, outp, nullptr, AIN(I_LFG) + l * D, AIN(I_LFB) + l * D, nullptr, nullptr, gw, ngw, lane);
            }
        }
    }
}

extern "C" void kernel_launch(void* const* d_in, const int* in_sizes, int n_in, void* d_out, int out_size, void* d_ws, size_t ws_size, hipStream_t stream) {
    static int grid = 0;
    if (grid == 0) {
        if (n_in != 25 || in_sizes[0] != M * D || out_size != M * D || ws_size < WS_END) {
            fprintf(stderr, "kernel_launch: unexpected shapes: n_in %d in0 %d out %d ws %zu (need %zu); nothing launched\n", n_in, n_in > 0 ? in_sizes[0] : -1, out_size, ws_size, (size_t)WS_END); grid = -1; return; }
        int dev = 0, cus = 0, per_cu = 0;
        if (hipGetDevice(&dev) != hipSuccess || hipDeviceGetAttribute(&cus, hipDeviceAttributeMultiprocessorCount, dev) != hipSuccess) { grid = -1; return; }
        if (hipFuncSetAttribute((const void*)fwd, hipFuncAttributeMaxDynamicSharedMemorySize, LDS_BYTES) != hipSuccess) { fprintf(stderr, "kernel_launch: hipFuncSetAttribute failed\n"); grid = -1; return; }
        if (hipOccupancyMaxActiveBlocksPerMultiprocessor(&per_cu, (const void*)fwd, 512, LDS_BYTES) != hipSuccess || per_cu < 1) { fprintf(stderr, "kernel_launch: occupancy query says %d blocks per CU\n", per_cu); (void)hipGetLastError(); grid = -1; return; }
        grid = cus;
    }
    if (grid < 0) return;
    Args a{};
    for (int i = 0; i < 25; ++i) a.in[i] = (const float*)d_in[i];
    a.out = (float*)d_out; a.ws = (unsigned char*)d_ws;
#if MK_ONE_LAUNCH
    a.ph_lo = 0; a.ph_hi = NPH;
    void* args[] = {&a};
    hipError_t e = hipLaunchCooperativeKernel((const void*)fwd, dim3(grid), dim3(512), args, LDS_BYTES, stream);
    if (e != hipSuccess) fprintf(stderr, "cooperative launch failed: %s (grid %d)\n", hipGetErrorString(e), grid);
#else
    for (int ph = 0; ph < NPH; ++ph) { a.ph_lo = ph; a.ph_hi = ph + 1; hipLaunchKernelGGL(fwd, dim3(grid), dim3(512), LDS_BYTES, stream, a); }
#endif
}
```

```cpp
#include <hip/hip_runtime.h>
#include <hip/hip_cooperative_groups.h>
#include <cstdio>
#include <cstdint>
namespace cg = cooperative_groups;

#ifndef MK_ONE_LAUNCH
#define MK_ONE_LAUNCH 1
#endif

#define LAS __attribute__((address_space(3)))
typedef unsigned short bf16_t;
typedef short bf16x8 __attribute__((ext_vector_type(8)));
typedef float f32x4 __attribute__((ext_vector_type(4)));
typedef float f32x16 __attribute__((ext_vector_type(16)));
typedef unsigned u32x4 __attribute__((ext_vector_type(4)));
typedef unsigned u32x2 __attribute__((ext_vector_type(2)));

constexpr int M = 32768, D = 1024, SEQ = 4096, DFF = 4096, DEPTH = 2;
constexpr int ZM_LD = 1792, ZG_LD = 3072;
constexpr int NWIN = 4864;
constexpr float ALPHA = 1.4142135623730951f;
constexpr float LN_EPS = 1e-5f;
constexpr float LOG2E = 1.4426950408889634f;
constexpr float QSCALE = 0.125f * LOG2E;

constexpr size_t MiB = 1u << 20;
constexpr size_t WS_MOD = 1 * MiB;
constexpr size_t WS_W = 2 * MiB, WS_WL = 31 * MiB;
constexpr size_t W_IN = 0, W_V = 9 * MiB + MiB / 2, W_BP = 10 * MiB + MiB / 2, W_BA = 11 * MiB, W_BC = 12 * MiB, W_O = 12 * MiB + MiB / 2, W_1 = 14 * MiB + MiB / 2, W_2 = 22 * MiB + MiB / 2;
constexpr size_t WS_UB = 64 * MiB;
constexpr size_t WS_ZM = 128 * MiB;
constexpr size_t WS_VT = 240 * MiB;
constexpr size_t WS_ZG = 272 * MiB;
constexpr size_t WS_H = 128 * MiB;
constexpr size_t WS_MG = 128 * MiB;
constexpr size_t WS_END = 464 * MiB;

constexpr int LDS_BYTES = 147456;
constexpr int NPH = 2 + 8 * DEPTH;

typedef float f32x2_t __attribute__((ext_vector_type(2))); typedef __bf16 bf16x2_t __attribute__((ext_vector_type(2)));
__device__ __forceinline__ unsigned cvt_pk_bf16(float lo, float hi) { f32x2_t v = {lo, hi}; bf16x2_t b = __builtin_convertvector(v, bf16x2_t); return __builtin_bit_cast(unsigned, b); }
__device__ __forceinline__ float bf_lo(unsigned u) { return __uint_as_float(u << 16); }
__device__ __forceinline__ float bf_hi(unsigned u) { return __uint_as_float(u & 0xffff0000u); }
__device__ __forceinline__ float sigmoid_f(float x) { return __builtin_amdgcn_rcpf(1.f + __builtin_amdgcn_exp2f(-LOG2E * x)); }
__device__ __forceinline__ unsigned f2bf(float f) { unsigned u = __builtin_bit_cast(unsigned, f); return (u + 0x7fffu + ((u >> 16) & 1u)) >> 16; }
__device__ __forceinline__ float wave_sum(float v) {
#pragma unroll
    for (int o = 1; o < 64; o <<= 1) v += __shfl_xor(v, o);
    return v;
}
#define LDS_WAIT() asm volatile("s_waitcnt lgkmcnt(0)" ::: "memory")

namespace pg8 {
constexpr int BM = 256, BK = 64, HALF = 128, HTB = HALF * BK * 2, STAGE_BYTES = 8 * HTB, NXCD = 8, WGM = 8;
__host__ __device__ __forceinline__ int lds_byte(int r, int c) { const int st = (r >> 4) * 2 + (c >> 5), rr = r & 15, cc = c & 31, ob = rr * 64 + cc * 2; return st * 1024 + (ob ^ (((ob >> 9) & 1) << 5)); }
__host__ __device__ __forceinline__ void stage_rc(int b, int& R, int& C) { const int st = b / 1024, sb = b % 1024, swz = sb ^ (((sb >> 9) & 1) << 5); R = (st >> 1) * 16 + swz / 64; C = (st & 1) * 32 + (swz % 64) / 2; }
__host__ __device__ __forceinline__ int perm32(int rho) { const int n = rho >> 4, i = rho & 15; return 8 * (i >> 2) + 4 * n + (i & 3); }

struct Unit { int pm, pn; };
struct Gemm { const bf16_t* A; const bf16_t* Bt; int M, N, K, lda, ldb; };

struct StaticOrder {
    int nM, nN, nwg, G, c;
    __host__ __device__ void init(int M_, int N_, int G_, int c_) { nM = M_ / BM; nN = N_ / BM; nwg = nM * nN; G = G_; c = c_; }
    __host__ __device__ bool next(int i, Unit& u) const {
        const long L = (long)i * G + c; if (L >= nwg) return false;
        int wgid = (int)L; { const int q = nwg / NXCD, r = nwg % NXCD, xcd = wgid % NXCD, off = wgid / NXCD; wgid = (xcd < r ? xcd * (q + 1) : r * (q + 1) + (xcd - r) * q) + off; }
        const int nig = WGM * nN, gid = wgid / nig, fm = gid * WGM, gsz = (nM - fm) < WGM ? (nM - fm) : WGM;
        u.pm = fm + ((wgid % nig) % gsz); u.pn = (wgid % nig) / gsz; return true;
    }
};

typedef f32x4 Acc[2][2][4][2];

template <class Epi>
__device__ __forceinline__ void gemm_phase(LAS unsigned char* lds, const int tid, const Gemm g, const StaticOrder& S, const Epi& E) {
    const int wid = __builtin_amdgcn_readfirstlane(tid >> 6), lane = tid & 63, wr = wid >> 2, wc = wid & 3, fr = lane & 15, fq = lane >> 4;
    const int K = g.K, nt = K / BK;
    unsigned voffA[2], voffB[2];
#pragma unroll
    for (int i = 0; i < 2; ++i) { int R, C; stage_rc(tid * 16 + i * 8192, R, C); const int Rb = Epi::PERM ? ((R & ~31) + perm32(R & 31)) : R;
        voffA[i] = (unsigned)(R * g.lda + C) * 2u; voffB[i] = (unsigned)(Rb * g.ldb + C) * 2u; }
    const size_t kstep = (size_t)(BK * 2);
    const size_t hA = (size_t)HALF * g.lda * 2, hB = (size_t)HALF * g.ldb * 2;
    const size_t tA = 2 * hA, tB = 2 * hB;
    const unsigned ldsw = (unsigned)wid * 1024u;
    const int aoff = lds_byte(wr * 64 + fr, fq * 8), boff = lds_byte(wc * 32 + fr, fq * 8);
#define PG8_SA(b, h) (((b) * 2 + (h)) * HTB)
#define PG8_SB(b, h) ((4 + (b) * 2 + (h)) * HTB)
#define PG8_STAGE(bufoff, gbase, voff) do { _Pragma("unroll") for (int _i = 0; _i < 2; ++_i) \
        __builtin_amdgcn_global_load_lds((const unsigned*)((const char*)(gbase) + (voff)[_i]), (LAS unsigned*)(lds + (bufoff) + ldsw + _i * 8192), 16, 0, 0); } while (0)
#define PG8_LDA(dst, b, h) do { _Pragma("unroll") for (int m = 0; m < 4; ++m) _Pragma("unroll") for (int k = 0; k < 2; ++k) dst[m][k] = *(const LAS bf16x8*)(lds + PG8_SA(b, h) + aoff + m * 2048 + k * 1024); } while (0)
#define PG8_LDB(dst, b, h) do { _Pragma("unroll") for (int n = 0; n < 2; ++n) _Pragma("unroll") for (int k = 0; k < 2; ++k) dst[n][k] = *(const LAS bf16x8*)(lds + PG8_SB(b, h) + boff + n * 2048 + k * 1024); } while (0)
#define PG8_MMA(ai, bj, At, Bt) do { __builtin_amdgcn_s_setprio(1); _Pragma("unroll") for (int m = 0; m < 4; ++m) _Pragma("unroll") for (int n = 0; n < 2; ++n) _Pragma("unroll") for (int k = 0; k < 2; ++k) \
        acc[ai][bj][m][n] = __builtin_amdgcn_mfma_f32_16x16x32_bf16(Bt[n][k], At[m][k], acc[ai][bj][m][n], 0, 0, 0); __builtin_amdgcn_s_setprio(0); } while (0)
#define PG8_WAIT_V(n) asm volatile("s_waitcnt vmcnt(" #n ")" ::: "memory")
#define PG8_WAIT_L(n) asm volatile("s_waitcnt lgkmcnt(" #n ")" ::: "memory")
#define PG8_BAR __builtin_amdgcn_s_barrier()
#define PG8_SCHED __builtin_amdgcn_sched_barrier(0)
    Unit cur, nxt; int ui = 0;
    if (!S.next(0, cur)) return;
    Acc acc;
#pragma unroll
    for (int a = 0; a < 2; ++a)
#pragma unroll
        for (int b = 0; b < 2; ++b)
#pragma unroll
            for (int m = 0; m < 4; ++m)
#pragma unroll
                for (int n = 0; n < 2; ++n) acc[a][b][m][n] = (f32x4){0.f, 0.f, 0.f, 0.f};
    bf16x8 At[4][2], B0[2][2], B1[2][2];
    const char* cA = (const char*)g.A + (size_t)cur.pm * tA; const char* cB = (const char*)g.Bt + (size_t)cur.pn * tB;
    PG8_STAGE(PG8_SB(0, 0), cB, voffB); PG8_STAGE(PG8_SB(0, 1), cB + hB, voffB); PG8_STAGE(PG8_SA(0, 0), cA, voffA); PG8_STAGE(PG8_SA(0, 1), cA + hA, voffA);
    if (wr == 1) PG8_BAR;
    PG8_WAIT_V(2); PG8_BAR;
    PG8_STAGE(PG8_SB(1, 0), cB + kstep, voffB); PG8_STAGE(PG8_SA(1, 0), cA + kstep, voffA); PG8_STAGE(PG8_SB(1, 1), cB + hB + kstep, voffB);
    PG8_WAIT_V(6); PG8_BAR;
    for (;;) {
        const bool has_next = S.next(ui + 1, nxt);
        const char* nA = has_next ? (const char*)g.A + (size_t)nxt.pm * tA : cA; const char* nB = has_next ? (const char*)g.Bt + (size_t)nxt.pn * tB : cB;
        for (int t = 0; t < nt; t += 2) {
            const bool last = (t == nt - 2);
            const char* a1 = cA + (size_t)(t + 1) * kstep;
            const char* a2 = last ? nA : cA + (size_t)(t + 2) * kstep; const char* b2 = last ? nB : cB + (size_t)(t + 2) * kstep;
            const char* a3 = a2 + kstep; const char* b3 = b2 + kstep;
            PG8_LDB(B0, 0, 0); PG8_LDB(B1, 0, 1); PG8_SCHED; PG8_LDA(At, 0, 0); PG8_STAGE(PG8_SA(1, 1), a1 + hA, voffA);
            PG8_WAIT_V(8); PG8_WAIT_L(0); PG8_BAR; PG8_MMA(0, 0, At, B0); PG8_MMA(0, 1, At, B1); PG8_BAR; PG8_SCHED;
            PG8_LDA(At, 0, 1); PG8_STAGE(PG8_SB(0, 0), b2, voffB); PG8_STAGE(PG8_SB(0, 1), b2 + hB, voffB); PG8_STAGE(PG8_SA(0, 0), a2, voffA);
            PG8_WAIT_V(8); PG8_WAIT_L(0); PG8_BAR; PG8_MMA(1, 0, At, B0); PG8_MMA(1, 1, At, B1); PG8_BAR; PG8_SCHED;
            PG8_LDB(B0, 1, 0); PG8_LDB(B1, 1, 1); PG8_SCHED; PG8_LDA(At, 1, 0); PG8_STAGE(PG8_SA(0, 1), a2 + hA, voffA);
            PG8_WAIT_V(8); PG8_WAIT_L(0); PG8_BAR; PG8_MMA(0, 0, At, B0); PG8_MMA(0, 1, At, B1); PG8_BAR; PG8_SCHED;
            PG8_LDA(At, 1, 1); PG8_STAGE(PG8_SB(1, 0), b3, voffB); PG8_STAGE(PG8_SB(1, 1), b3 + hB, voffB); PG8_STAGE(PG8_SA(1, 0), a3, voffA);
            PG8_WAIT_V(8); PG8_WAIT_L(0); PG8_BAR; PG8_MMA(1, 0, At, B0); PG8_MMA(1, 1, At, B1); PG8_BAR; PG8_SCHED;
        }
        if (wr == 0) PG8_BAR;
        E(acc, cur, wr, wc, fr, fq);
        if (!has_next) break;
#pragma unroll
        for (int a = 0; a < 2; ++a)
#pragma unroll
            for (int b = 0; b < 2; ++b)
#pragma unroll
                for (int m = 0; m < 4; ++m)
#pragma unroll
                    for (int n = 0; n < 2; ++n) acc[a][b][m][n] = (f32x4){0.f, 0.f, 0.f, 0.f};
        cur = nxt; cA = nA; cB = nB; ++ui;
        if (wr == 1) PG8_BAR;
    }
    PG8_WAIT_V(0);
    PG8_BAR;
#undef PG8_SA
#undef PG8_SB
#undef PG8_STAGE
#undef PG8_LDA
#undef PG8_LDB
#undef PG8_MMA
#undef PG8_WAIT_V
#undef PG8_WAIT_L
#undef PG8_BAR
#undef PG8_SCHED
}

struct EpiZ {
    static constexpr bool PERM = true;
    bf16_t* zm; bf16_t* zg; const float* bgate;
    __device__ __forceinline__ void operator()(const Acc& acc, const Unit& u, int wr, int wc, int fr, int fq) const {
        const int row0 = u.pm * BM + wr * 64 + fr;
        if (u.pn < 7) {
            const float sc = (u.pn == 1 || u.pn == 2) ? QSCALE : 1.f;
            const int col0 = u.pn * BM + wc * 32 + 8 * fq;
#pragma unroll
            for (int ai = 0; ai < 2; ++ai)
#pragma unroll
                for (int m = 0; m < 4; ++m) { bf16_t* rowp = zm + (size_t)(row0 + ai * HALF + m * 16) * ZM_LD + col0;
#pragma unroll
                    for (int bj = 0; bj < 2; ++bj) { const f32x4 v0 = acc[ai][bj][m][0] * sc, v1 = acc[ai][bj][m][1] * sc;
                        u32x4 w; w.x = cvt_pk_bf16(v0[0], v0[1]); w.y = cvt_pk_bf16(v0[2], v0[3]); w.z = cvt_pk_bf16(v1[0], v1[1]); w.w = cvt_pk_bf16(v1[2], v1[3]);
                        *(u32x4*)(rowp + bj * HALF) = w; } }
        } else {
            const int col0 = (u.pn - 7) * BM + wc * 32 + 8 * fq;
            f32x4 bv[2][2];
#pragma unroll
            for (int bj = 0; bj < 2; ++bj)
#pragma unroll
                for (int n = 0; n < 2; ++n) bv[bj][n] = *(const f32x4*)(bgate + col0 + bj * HALF + 4 * n);
#pragma unroll
            for (int ai = 0; ai < 2; ++ai)
#pragma unroll
                for (int m = 0; m < 4; ++m) { bf16_t* rowp = zg + (size_t)(row0 + ai * HALF + m * 16) * ZG_LD + col0;
#pragma unroll
                    for (int bj = 0; bj < 2; ++bj) { f32x4 v0 = acc[ai][bj][m][0] + bv[bj][0], v1 = acc[ai][bj][m][1] + bv[bj][1];
#pragma unroll
                        for (int e = 0; e < 4; ++e) { v0[e] = sigmoid_f(v0[e]); v1[e] = sigmoid_f(v1[e]); }
                        u32x4 w; w.x = cvt_pk_bf16(v0[0], v0[1]); w.y = cvt_pk_bf16(v0[2], v0[3]); w.z = cvt_pk_bf16(v1[0], v1[1]); w.w = cvt_pk_bf16(v1[2], v1[3]);
                        *(u32x4*)(rowp + bj * HALF) = w; } }
        }
    }
};
template <int ACT> struct EpiBf16 {
    static constexpr bool PERM = true;
    bf16_t* O; int ldc; const float* bias;
    __device__ __forceinline__ void operator()(const Acc& acc, const Unit& u, int wr, int wc, int fr, int fq) const {
        const int row0 = u.pm * BM + wr * 64 + fr, col0 = u.pn * BM + wc * 32 + 8 * fq;
        f32x4 bv[2][2];
#pragma unroll
        for (int bj = 0; bj < 2; ++bj)
#pragma unroll
            for (int n = 0; n < 2; ++n) bv[bj][n] = ACT ? *(const f32x4*)(bias + col0 + bj * HALF + 4 * n) : (f32x4){0.f, 0.f, 0.f, 0.f};
#pragma unroll
        for (int ai = 0; ai < 2; ++ai)
#pragma unroll
            for (int m = 0; m < 4; ++m) { bf16_t* rowp = O + (size_t)(row0 + ai * HALF + m * 16) * ldc + col0;
#pragma unroll
                for (int bj = 0; bj < 2; ++bj) { f32x4 v0 = acc[ai][bj][m][0] + bv[bj][0], v1 = acc[ai][bj][m][1] + bv[bj][1];
                    if (ACT) {
#pragma unroll
                        for (int e = 0; e < 4; ++e) { const float a = fmaxf(v0[e], 0.f), b = fmaxf(v1[e], 0.f); v0[e] = a * a; v1[e] = b * b; } }
                    u32x4 w; w.x = cvt_pk_bf16(v0[0], v0[1]); w.y = cvt_pk_bf16(v0[2], v0[3]); w.z = cvt_pk_bf16(v1[0], v1[1]); w.w = cvt_pk_bf16(v1[2], v1[3]);
                    *(u32x4*)(rowp + bj * HALF) = w; } }
    }
};
struct EpiGate {
    static constexpr bool PERM = true;
    bf16_t* mg; const bf16_t* zg; int first;
    __device__ __forceinline__ void operator()(const Acc& acc, const Unit& u, int wr, int wc, int fr, int fq) const {
        const int row0 = u.pm * BM + wr * 64 + fr, col0 = u.pn * BM + wc * 32 + 8 * fq;
#pragma unroll
        for (int ai = 0; ai < 2; ++ai)
#pragma unroll
            for (int m = 0; m < 4; ++m) { const size_t r = (size_t)(row0 + ai * HALF + m * 16);
#pragma unroll
                for (int bj = 0; bj < 2; ++bj) {
                    const u32x4 gv = *(const u32x4*)(zg + r * ZG_LD + col0 + bj * HALF);
                    bf16_t* mp = mg + r * D + col0 + bj * HALF;
                    u32x4 ov = (u32x4){0u, 0u, 0u, 0u}; if (!first) ov = *(const u32x4*)mp;
                    const f32x4 a0 = acc[ai][bj][m][0], a1 = acc[ai][bj][m][1];
                    u32x4 w;
                    w.x = cvt_pk_bf16(bf_lo(ov.x) + bf_lo(gv.x) * a0[0], bf_hi(ov.x) + bf_hi(gv.x) * a0[1]);
                    w.y = cvt_pk_bf16(bf_lo(ov.y) + bf_lo(gv.y) * a0[2], bf_hi(ov.y) + bf_hi(gv.y) * a0[3]);
                    w.z = cvt_pk_bf16(bf_lo(ov.z) + bf_lo(gv.z) * a1[0], bf_hi(ov.z) + bf_hi(gv.z) * a1[1]);
                    w.w = cvt_pk_bf16(bf_lo(ov.w) + bf_lo(gv.w) * a1[2], bf_hi(ov.w) + bf_hi(gv.w) * a1[3]);
                    *(u32x4*)mp = w; } }
    }
};
struct EpiRes {
    static constexpr bool PERM = false;
    const float* xin; float* out; const float* gvec; const float* bias;
    __device__ __forceinline__ void operator()(const Acc& acc, const Unit& u, int wr, int wc, int fr, int fq) const {
        const int row0 = u.pm * BM + wr * 64 + fr, col0 = u.pn * BM + wc * 32 + 4 * fq;
        const float* gp = gvec + (size_t)(u.pm >> 4) * 6144;
#pragma unroll
        for (int bj = 0; bj < 2; ++bj)
#pragma unroll
            for (int n = 0; n < 2; ++n) { const int col = col0 + bj * HALF + n * 16;
                const f32x4 gv = *(const f32x4*)(gp + col); const f32x4 bv = bias ? *(const f32x4*)(bias + col) : (f32x4){0.f, 0.f, 0.f, 0.f};
#pragma unroll
                for (int ai = 0; ai < 2; ++ai)
#pragma unroll
                    for (int m = 0; m < 4; ++m) { const size_t off = (size_t)(row0 + ai * HALF + m * 16) * D + col;
                        const f32x4 xv = *(const f32x4*)(xin + off);
                        *(f32x4*)(out + off) = xv * ALPHA + gv * (acc[ai][bj][m][n] + bv); } }
    }
};
}

struct Args { const float* in[25]; float* out; unsigned char* ws; int ph_lo, ph_hi; };
enum { I_X = 0, I_C, I_WADA, I_BADA, I_WIN, I_BGATE, I_WPOOL, I_PSCALE, I_RELB, I_CONVW, I_CONVB, I_CLNG, I_CLNB, I_WBP, I_WBA, I_WBC, I_WO, I_LMG, I_LMB, I_W1, I_B1, I_W2, I_B2, I_LFG, I_LFB };

__device__ __forceinline__ void tr_item(const float* W, int N, int k0, int n0, bf16_t* dst, int dK, LAS float* scr, int lane) {
#pragma unroll 8
    for (int i = 0; i < 32; ++i) { const int kk = 2 * i + (lane >> 5); scr[kk * 33 + (lane & 31)] = W[(size_t)(k0 + kk) * N + n0 + (lane & 31)]; }
    LDS_WAIT();
    const int c = lane & 7;
#pragma unroll
    for (int j = 0; j < 4; ++j) { const int n = (lane >> 3) + 8 * j; const LAS float* s = scr + (8 * c) * 33 + n;
        u32x4 o; o.x = f2bf(s[0 * 33]) | (f2bf(s[1 * 33]) << 16); o.y = f2bf(s[2 * 33]) | (f2bf(s[3 * 33]) << 16); o.z = f2bf(s[4 * 33]) | (f2bf(s[5 * 33]) << 16); o.w = f2bf(s[6 * 33]) | (f2bf(s[7 * 33]) << 16);
        *(u32x4*)(dst + (size_t)n * dK + 8 * c) = o; }
    LDS_WAIT();
}

template <int MODE>
__device__ __forceinline__ void ln_pass(const float* src, float* dst, bf16_t* u, const float* g, const float* bb, const float* modsc, const float* modsh, int gw, int ngw, int lane) {
    for (int row0 = gw * 16; row0 < M; row0 += ngw * 16) {
        const int batch = row0 >> 12;
        f32x4 gv[4], bv[4], scv[4], shv[4];
#pragma unroll
        for (int j = 0; j < 4; ++j) {
            if (MODE >= 1) { gv[j] = *(const f32x4*)(g + 4 * lane + 256 * j); bv[j] = *(const f32x4*)(bb + 4 * lane + 256 * j); }
            if (MODE != 2) { scv[j] = *(const f32x4*)(modsc + (size_t)batch * 6144 + 4 * lane + 256 * j) + 1.f; shv[j] = *(const f32x4*)(modsh + (size_t)batch * 6144 + 4 * lane + 256 * j); }
        }
        f32x4 nv[4];
#pragma unroll
        for (int j = 0; j < 4; ++j) nv[j] = *(const f32x4*)(src + (size_t)row0 * D + 4 * lane + 256 * j);
        for (int r = 0; r < 16; ++r) {
            const size_t off = (size_t)(row0 + r) * D + 4 * lane;
            f32x4 v[4];
#pragma unroll
            for (int j = 0; j < 4; ++j) v[j] = nv[j];
            if (r < 15) {
#pragma unroll
                for (int j = 0; j < 4; ++j) nv[j] = *(const f32x4*)(src + off + D + 256 * j);
            }
            float s = 0.f;
#pragma unroll
            for (int j = 0; j < 4; ++j) s += (v[j].x + v[j].y) + (v[j].z + v[j].w);
            float mean = wave_sum(s) * (1.f / D), s2 = 0.f;
#pragma unroll
            for (int j = 0; j < 4; ++j) { v[j] = v[j] - mean; s2 += (v[j].x * v[j].x + v[j].y * v[j].y) + (v[j].z * v[j].z + v[j].w * v[j].w); }
            float rstd = 1.f / sqrtf(wave_sum(s2) * (1.f / D) + LN_EPS);
            if (MODE >= 1) {
                s = 0.f;
#pragma unroll
                for (int j = 0; j < 4; ++j) { v[j] = v[j] * rstd * gv[j] + bv[j]; *(f32x4*)(dst + off + 256 * j) = v[j]; s += (v[j].x + v[j].y) + (v[j].z + v[j].w); }
                if (MODE == 1) {
                    mean = wave_sum(s) * (1.f / D); s2 = 0.f;
#pragma unroll
                    for (int j = 0; j < 4; ++j) { v[j] = v[j] - mean; s2 += (v[j].x * v[j].x + v[j].y * v[j].y) + (v[j].z * v[j].z + v[j].w * v[j].w); }
                    rstd = 1.f / sqrtf(wave_sum(s2) * (1.f / D) + LN_EPS);
                }
            }
            if (MODE != 2) {
#pragma unroll
                for (int j = 0; j < 4; ++j) { const f32x4 o = v[j] * rstd * scv[j] + shv[j]; u32x2 w; w.x = cvt_pk_bf16(o.x, o.y); w.y = cvt_pk_bf16(o.z, o.w); *(u32x2*)(u + off + 256 * j) = w; }
            }
        }
    }
}

__device__ __forceinline__ void attn_wave(const bf16_t* zm, const bf16_t* vt, bf16_t* bcat, const LAS float* rb  , int b, int n, int h, int qh, int lane) {
    const int r32 = lane & 31, hi = lane >> 5;
    const size_t tok0 = (size_t)b * SEQ + (size_t)n * 64;
    const bf16_t* qp = zm + (tok0 + qh * 32 + r32) * ZM_LD + 256 + h * 64 + hi * 8;
    bf16x8 qf[4];
#pragma unroll
    for (int d0 = 0; d0 < 4; ++d0) qf[d0] = *(const bf16x8*)(qp + d0 * 16);
    const int pi = (r32 & ~12) | ((r32 & 4) << 1) | ((r32 & 8) >> 1);
    float m_run = -1e30f, l_run = 0.f;
    f32x16 o[2];
#pragma unroll
    for (int r = 0; r < 16; ++r) { o[0][r] = 0.f; o[1][r] = 0.f; }
    const int qi = qh * 32 + r32;
    const int jlo = n < 8 ? 8 - n : 0;
    for (int j = jlo; j <= 8; ++j) {
        const int delta = 8 - j;
        const size_t kt0 = tok0 - (size_t)delta * 64;
        bf16x8 kf[2][4], vf[2][4];
#pragma unroll
        for (int kb = 0; kb < 2; ++kb) { const bf16_t* kp = zm + (kt0 + kb * 32 + pi) * ZM_LD + 768 + h * 64 + hi * 8;
#pragma unroll
            for (int d0 = 0; d0 < 4; ++d0) kf[kb][d0] = *(const bf16x8*)(kp + d0 * 16); }
#pragma unroll
        for (int db = 0; db < 2; ++db) { const bf16_t* vp = vt + (size_t)(h * 64 + db * 32 + r32) * M + kt0 + hi * 8;
#pragma unroll
            for (int c = 0; c < 4; ++c) vf[db][c] = *(const bf16x8*)(vp + c * 16); }
        f32x16 s[2];
#pragma unroll
        for (int kb = 0; kb < 2; ++kb) {
#pragma unroll
            for (int r = 0; r < 16; ++r) s[kb][r] = 0.f;
#pragma unroll
            for (int d0 = 0; d0 < 4; ++d0) s[kb] = __builtin_amdgcn_mfma_f32_32x32x16_bf16(kf[kb][d0], qf[d0], s[kb], 0, 0, 0);
        }
        if (delta >= 3) {
            const float cb = rb[256];
#pragma unroll
            for (int kb = 0; kb < 2; ++kb)
#pragma unroll
                for (int r = 0; r < 16; ++r) s[kb][r] += cb;
        } else {
            const int base = delta * 64 + qi - 8 * hi;
#pragma unroll
            for (int kb = 0; kb < 2; ++kb)
#pragma unroll
                for (int r = 0; r < 16; ++r) { int dd = base - (kb * 32 + 16 * (r >> 3) + (r & 7)); dd = dd > 128 ? 128 : dd; s[kb][r] += rb[dd + 128]; }
        }
        float mx = s[0][0];
#pragma unroll
        for (int kb = 0; kb < 2; ++kb)
#pragma unroll
            for (int r = 0; r < 16; ++r) mx = fmaxf(mx, s[kb][r]);
        mx = fmaxf(mx, __shfl_xor(mx, 32));
        const float m_new = fmaxf(m_run, mx);
        const float f = __builtin_amdgcn_exp2f(m_run - m_new);
        m_run = m_new;
        float ps = 0.f;
#pragma unroll
        for (int kb = 0; kb < 2; ++kb)
#pragma unroll
            for (int r = 0; r < 16; ++r) { s[kb][r] = __builtin_amdgcn_exp2f(s[kb][r] - m_new); ps += s[kb][r]; }
        l_run = l_run * f + ps;
#pragma unroll
        for (int r = 0; r < 16; ++r) { o[0][r] *= f; o[1][r] *= f; }
        bf16x8 pf[4];
#pragma unroll
        for (int c = 0; c < 4; ++c) { const int kb = c >> 1, s8 = (c & 1) * 8; u32x4 w;
            w.x = cvt_pk_bf16(s[kb][s8 + 0], s[kb][s8 + 1]); w.y = cvt_pk_bf16(s[kb][s8 + 2], s[kb][s8 + 3]); w.z = cvt_pk_bf16(s[kb][s8 + 4], s[kb][s8 + 5]); w.w = cvt_pk_bf16(s[kb][s8 + 6], s[kb][s8 + 7]);
            pf[c] = __builtin_bit_cast(bf16x8, w); }
#pragma unroll
        for (int db = 0; db < 2; ++db)
#pragma unroll
            for (int c = 0; c < 4; ++c) o[db] = __builtin_amdgcn_mfma_f32_32x32x16_bf16(vf[db][c], pf[c], o[db], 0, 0, 0);
    }
    const float l = l_run + __shfl_xor(l_run, 32);
    const float inv = 1.f / l;
    bf16_t* op = bcat + (tok0 + qh * 32 + r32) * D + 256 + h * 64 + 4 * hi;
#pragma unroll
    for (int db = 0; db < 2; ++db)
#pragma unroll
        for (int g4 = 0; g4 < 4; ++g4) { u32x2 w; w.x = cvt_pk_bf16(o[db][4 * g4 + 0] * inv, o[db][4 * g4 + 1] * inv); w.y = cvt_pk_bf16(o[db][4 * g4 + 2] * inv, o[db][4 * g4 + 3] * inv);
            *(u32x2*)(op + db * 32 + 8 * g4) = w; }
}


template <int W>
__device__ __forceinline__ void pool_item(const bf16_t* zm, bf16_t* ub, int r, int c0) {
    const int t = r & (SEQ - 1), cnt = (t + 1) < W ? (t + 1) : W;
    const bf16_t* p = zm + (size_t)r * ZM_LD + c0;
    u32x4 v[W];
#pragma unroll
    for (int i = 0; i < W; ++i) { v[i] = (u32x4){0u, 0u, 0u, 0u}; if (i < cnt) v[i] = *(const u32x4*)(p - (size_t)i * ZM_LD); }
    float s[8];
#pragma unroll
    for (int e = 0; e < 8; ++e) s[e] = 0.f;
#pragma unroll
    for (int i = 0; i < W; ++i) { s[0] += bf_lo(v[i].x); s[1] += bf_hi(v[i].x); s[2] += bf_lo(v[i].y); s[3] += bf_hi(v[i].y); s[4] += bf_lo(v[i].z); s[5] += bf_hi(v[i].z); s[6] += bf_lo(v[i].w); s[7] += bf_hi(v[i].w); }
    const float inv = 1.f / (float)cnt;
    u32x4 o; o.x = cvt_pk_bf16(s[0] * inv - bf_lo(v[0].x), s[1] * inv - bf_hi(v[0].x)); o.y = cvt_pk_bf16(s[2] * inv - bf_lo(v[0].y), s[3] * inv - bf_hi(v[0].y));
    o.z = cvt_pk_bf16(s[4] * inv - bf_lo(v[0].z), s[5] * inv - bf_hi(v[0].z)); o.w = cvt_pk_bf16(s[6] * inv - bf_lo(v[0].w), s[7] * inv - bf_hi(v[0].w));
    *(u32x4*)(ub + (size_t)r * D + c0) = o;
}

__device__ __forceinline__ void conv_unit(LAS unsigned char* lds, const bf16_t* zm, bf16_t* bcat, const float* cw, const float* cb, const float* lg, const float* lb, int unit, int tid, int wave, int lane) {
    LAS float* hbuf = (LAS float*)(lds + 16384);
    LAS float* obuf = (LAS float*)(lds + 16384 + 62 * 256 * 4);
    const int b = unit >> 7, t0 = (unit & 127) * 32;
    for (int it = tid; it < 62 * 32; it += 512) {
        const int i = it >> 5, c8 = (it & 31) * 8, t = t0 - 30 + i;
        f32x4 h0 = (f32x4){0.f, 0.f, 0.f, 0.f}, h1 = h0;
        if (t >= 0) {
            const bf16_t* p = zm + ((size_t)b * SEQ + t) * ZM_LD + 1280 + c8;
            const u32x4 av = *(const u32x4*)p, gv = *(const u32x4*)(p + 256);
            h0 = (f32x4){bf_lo(av.x) * sigmoid_f(bf_lo(gv.x)), bf_hi(av.x) * sigmoid_f(bf_hi(gv.x)), bf_lo(av.y) * sigmoid_f(bf_lo(gv.y)), bf_hi(av.y) * sigmoid_f(bf_hi(gv.y))};
            h1 = (f32x4){bf_lo(av.z) * sigmoid_f(bf_lo(gv.z)), bf_hi(av.z) * sigmoid_f(bf_hi(gv.z)), bf_lo(av.w) * sigmoid_f(bf_lo(gv.w)), bf_hi(av.w) * sigmoid_f(bf_hi(gv.w))};
        }
        *(LAS f32x4*)(hbuf + i * 256 + c8) = h0; *(LAS f32x4*)(hbuf + i * 256 + c8 + 4) = h1;
    }
    __syncthreads();
    {
        const int c = tid & 255, th = tid >> 8;
        float w[31];
#pragma unroll
        for (int j = 0; j < 31; ++j) w[j] = cw[j * 256 + c];
        float acc[16]; const float bias = cb[c];
#pragma unroll
        for (int tt = 0; tt < 16; ++tt) acc[tt] = bias;
#pragma unroll
        for (int i = 0; i < 46; ++i) { const float hv = hbuf[(th * 16 + i) * 256 + c];
#pragma unroll
            for (int tt = 0; tt < 16; ++tt) { if (i - tt >= 0 && i - tt <= 30) acc[tt] += hv * w[i - tt]; } }
#pragma unroll
        for (int tt = 0; tt < 16; ++tt) obuf[(th * 16 + tt) * 256 + c] = acc[tt];
    }
    __syncthreads();
    {
        const f32x4 g4 = *(const f32x4*)(lg + 4 * lane), b4 = *(const f32x4*)(lb + 4 * lane);
#pragma unroll
        for (int k = 0; k < 4; ++k) { const int tok = wave * 4 + k;
            f32x4 v = *(const LAS f32x4*)(obuf + tok * 256 + 4 * lane);
            const float mean = wave_sum((v.x + v.y) + (v.z + v.w)) * (1.f / 256.f);
            v = v - mean;
            const float var = wave_sum((v.x * v.x + v.y * v.y) + (v.z * v.z + v.w * v.w)) * (1.f / 256.f);
            const float rstd = 1.f / sqrtf(var + LN_EPS);
            f32x4 y = v * rstd * g4 + b4;
#pragma unroll
            for (int e = 0; e < 4; ++e) y[e] = y[e] * sigmoid_f(y[e]);
            u32x2 wv; wv.x = cvt_pk_bf16(y.x, y.y); wv.y = cvt_pk_bf16(y.z, y.w);
            *(u32x2*)(bcat + ((size_t)b * SEQ + t0 + tok) * D + 768 + 4 * lane) = wv; }
    }
    __syncthreads();
}

__global__ void __launch_bounds__(512, 2) fwd(Args a) {
    extern __shared__ __attribute__((aligned(16))) unsigned char lds_raw[];
    LAS unsigned char* lds = (LAS unsigned char*)lds_raw;
    cg::grid_group grid = cg::this_grid();
    const int ph_lo = a.ph_lo, ph_hi = a.ph_hi;

    for (int ph = ph_lo; ph < ph_hi; ++ph) {
        if (ph > ph_lo) grid.sync();
        const __attribute__((address_space(4))) Args* ap = (const __attribute__((address_space(4))) Args*)__builtin_amdgcn_kernarg_segment_ptr();
        asm volatile("" : "+s"(ap));
        int tid = threadIdx.x; asm volatile("" : "+v"(tid));
        const int lane = tid & 63, wave = __builtin_amdgcn_readfirstlane(tid >> 6);
        const int G = gridDim.x, bx = blockIdx.x;
        const int vcu = (G % 8 == 0) ? (bx % 8) * (G / 8) + bx / 8 : bx;
        const int gw = vcu * 8 + wave, ngw = G * 8;
#define AIN(k) (ap->in[k])
        unsigned char* ws = ap->ws;
        float* mod = (float*)(ws + WS_MOD);
        bf16_t* UB = (bf16_t*)(ws + WS_UB); bf16_t* ZM = (bf16_t*)(ws + WS_ZM); bf16_t* VT = (bf16_t*)(ws + WS_VT); bf16_t* ZG = (bf16_t*)(ws + WS_ZG);
        bf16_t* HB = (bf16_t*)(ws + WS_H); bf16_t* MG = (bf16_t*)(ws + WS_MG);
        float* outp = ap->out;
        if (ph == 0) {
            LAS float* cact = (LAS float*)(lds + 98304);
            for (int i = tid; i < 8 * D; i += 512) { const float cv = AIN(I_C)[i]; cact[i] = cv * sigmoid_f(cv); }
            __syncthreads();
            LAS float* part = (LAS float*)(lds + 131072);
            for (int it = bx; it < 192; it += G) {
                const int l = it / 96, j = (it % 96) * 64 + lane;
                const float* W = AIN(I_WADA) + (size_t)l * D * 6144 + (size_t)(wave * 128) * 6144 + j;
                float acc[8];
#pragma unroll
                for (int b = 0; b < 8; ++b) acc[b] = 0.f;
                for (int k = 0; k < 128; k += 16) {
                    float wv[16];
#pragma unroll
                    for (int u = 0; u < 16; ++u) wv[u] = W[(size_t)(k + u) * 6144];
#pragma unroll
                    for (int b = 0; b < 8; ++b) {
#pragma unroll
                        for (int q = 0; q < 4; ++q) { const f32x4 c0 = *(const LAS f32x4*)(cact + b * D + wave * 128 + k + 4 * q);
                            acc[b] += (c0.x * wv[4 * q] + c0.y * wv[4 * q + 1]) + (c0.z * wv[4 * q + 2] + c0.w * wv[4 * q + 3]); } }
                }
#pragma unroll
                for (int b = 0; b < 8; ++b) part[(wave * 8 + b) * 64 + lane] = acc[b];
                __syncthreads();
                { float s = AIN(I_BADA)[l * 6144 + j];
#pragma unroll
                  for (int w = 0; w < 8; ++w) s += part[(w * 8 + wave) * 64 + lane];
                  mod[(size_t)(l * 8 + wave) * 6144 + j] = s; }
                __syncthreads();
            }
            LAS float* scr = (LAS float*)(lds + wave * 8704);
            constexpr int PER_L = 7680 + 128;
            for (int it = gw; it < DEPTH * PER_L; it += ngw) {
                const int l = it / PER_L; int r = it % PER_L;
                unsigned char* wl = ws + WS_W + (size_t)l * WS_WL;
                if (r < 2688) { const int k0 = (r / 168) * 64, n0 = (r % 168) * 32;
                    bf16_t* dst = (n0 >= 1280 && n0 < 1792) ? (bf16_t*)(wl + W_V) + (size_t)(n0 - 1280) * D + k0 : (bf16_t*)(wl + W_IN) + (size_t)(n0 >= 1792 ? n0 - 512 : n0) * D + k0;
                    tr_item(AIN(I_WIN) + (size_t)l * D * 5376, 5376, k0, n0, dst, D, scr, lane); continue; } r -= 2688;
                if (r < 256) { const int k0 = (r / 32) * 64, n0 = (r % 32) * 32; tr_item(AIN(I_WBA) + (size_t)l * 512 * D, D, k0, n0, (bf16_t*)(wl + W_BA) + (size_t)n0 * 512 + k0, 512, scr, lane); continue; } r -= 256;
                if (r < 128) { const int k0 = (r / 32) * 64, n0 = (r % 32) * 32; tr_item(AIN(I_WBC) + (size_t)l * 256 * D, D, k0, n0, (bf16_t*)(wl + W_BC) + (size_t)n0 * 256 + k0, 256, scr, lane); continue; } r -= 128;
                if (r < 512) { const int k0 = (r / 32) * 64, n0 = (r % 32) * 32; tr_item(AIN(I_WO) + (size_t)l * D * D, D, k0, n0, (bf16_t*)(wl + W_O) + (size_t)n0 * D + k0, D, scr, lane); continue; } r -= 512;
                if (r < 2048) { const int k0 = (r / 128) * 64, n0 = (r % 128) * 32; tr_item(AIN(I_W1) + (size_t)l * D * DFF, DFF, k0, n0, (bf16_t*)(wl + W_1) + (size_t)n0 * D + k0, D, scr, lane); continue; } r -= 2048;
                if (r < 2048) { const int k0 = (r / 32) * 64, n0 = (r % 32) * 32; tr_item(AIN(I_W2) + (size_t)l * DFF * D, D, k0, n0, (bf16_t*)(wl + W_2) + (size_t)n0 * DFF + k0, DFF, scr, lane); continue; } r -= 2048;
                {
                    const int g = r >> 5, n0 = (r & 31) * 32;
                    const float* ps = AIN(I_PSCALE) + l * 256 + g * 64; const float* wb = AIN(I_WBP) + (size_t)l * 256 * D + (size_t)(g * 64) * D + n0;
#pragma unroll 8
                    for (int i = 0; i < 32; ++i) { const int d = 2 * i + (lane >> 5), n = lane & 31; scr[n * 68 + d] = ps[d] * wb[(size_t)d * D + n]; }
                    LDS_WAIT();
                    f32x4 wpr[16]; const float* wp = AIN(I_WPOOL) + ((size_t)(l * 4 + g) * 64 + lane) * 64;
#pragma unroll
                    for (int q = 0; q < 16; ++q) wpr[q] = *(const f32x4*)(wp + 4 * q);
                    bf16_t* dst = (bf16_t*)(wl + W_BP) + (size_t)n0 * 256 + g * 64 + lane;
                    for (int n = 0; n < 32; ++n) { float acc = 0.f;
#pragma unroll
                        for (int q = 0; q < 16; ++q) { const f32x4 sv = *(const LAS f32x4*)(scr + n * 68 + 4 * q); acc += (wpr[q].x * sv.x + wpr[q].y * sv.y) + (wpr[q].z * sv.z + wpr[q].w * sv.w); }
                        dst[(size_t)n * 256] = (bf16_t)f2bf(acc); }
                    LDS_WAIT();
                }
            }
            __syncthreads();
        } else if (ph == 1) {
            ln_pass<0>(AIN(I_X), nullptr, UB, nullptr, nullptr, mod + 1 * D, mod + 0 * D, gw, ngw, lane);
        } else {
            const int l = (ph - 2) >> 3, sp = (ph - 2) & 7;
            unsigned char* wl = ws + WS_W + (size_t)l * WS_WL;
            const float* modl = mod + (size_t)l * 8 * 6144;
            if (sp == 0) {
                { pg8::Gemm g{UB, (const bf16_t*)(wl + W_IN), M, NWIN, D, D, D}; pg8::StaticOrder S; S.init(M, NWIN, G, bx);
                  pg8::EpiZ E{ZM, ZG, AIN(I_BGATE) + l * 3072};
                  pg8::gemm_phase(lds, tid, g, S, E); }
                { pg8::Gemm g{(const bf16_t*)(wl + W_V), UB, 512, M, D, D, D}; pg8::StaticOrder S; S.init(512, M, G, bx);
                  pg8::EpiBf16<0> E{VT, M, nullptr};
                  pg8::gemm_phase(lds, tid, g, S, E); }
            } else if (sp == 1) {
                LAS float* rbl = (LAS float*)lds;
                for (int i = tid; i < 8 * 257; i += 512) { const int h = i / 257, k = i % 257; rbl[h * 264 + k] = AIN(I_RELB)[(size_t)l * 8 * 257 + i] * LOG2E; }
                __syncthreads();
                for (int unit = vcu; unit < 512; unit += G) { const int b = unit >> 6, n = unit & 63;
                    attn_wave(ZM, VT, UB, rbl + wave * 264, b, n, wave, 0, lane);
                    attn_wave(ZM, VT, UB, rbl + wave * 264, b, n, wave, 1, lane); }
                for (int it = gw; it < (M / 8) * 4; it += ngw) {
                    const int gi = it & 3, r = (it >> 2) * 8 + (lane >> 3), c0 = gi * 64 + (lane & 7) * 8;
                    if (gi == 0) pool_item<2>(ZM, UB, r, c0); else if (gi == 1) pool_item<4>(ZM, UB, r, c0); else if (gi == 2) pool_item<8>(ZM, UB, r, c0); else pool_item<16>(ZM, UB, r, c0);
                }
                for (int unit = vcu; unit < 1024; unit += G)
                    conv_unit(lds, ZM, UB, AIN(I_CONVW) + l * 31 * 256, AIN(I_CONVB) + l * 256, AIN(I_CLNG) + l * 256, AIN(I_CLNB) + l * 256, unit, tid, wave, lane);
            } else if (sp == 2) {
                for (int br = 0; br < 3; ++br) {
                    const int K = br == 1 ? 512 : 256, aoff = br == 0 ? 0 : (br == 1 ? 256 : 768);
                    const bf16_t* Bt = (const bf16_t*)(wl + (br == 0 ? W_BP : (br == 1 ? W_BA : W_BC)));
                    pg8::Gemm g{UB + aoff, Bt, M, D, K, D, K}; pg8::StaticOrder S; S.init(M, D, G, bx);
                    pg8::EpiGate E{MG, ZG + br * D, br == 0};
                    pg8::gemm_phase(lds, tid, g, S, E);
                }
            } else if (sp == 3 || sp == 6) {
                const bool ff = (sp == 6);
                pg8::Gemm g{ff ? HB : MG, (const bf16_t*)(wl + (ff ? W_2 : W_O)), M, D, ff ? DFF : D, ff ? DFF : D, ff ? DFF : D}; pg8::StaticOrder S; S.init(M, D, G, bx);
                pg8::EpiRes E{(!ff && l == 0) ? AIN(I_X) : outp, outp, modl + (ff ? 5 : 2) * D, ff ? AIN(I_B2) + l * D : nullptr};
                pg8::gemm_phase(lds, tid, g, S, E);
            } else if (sp == 4) {
                ln_pass<1>(outp, outp, UB, AIN(I_LMG) + l * D, AIN(I_LMB) + l * D, modl + 4 * D, modl + 3 * D, gw, ngw, lane);
            } else if (sp == 5) {
                pg8::Gemm g{UB, (const bf16_t*)(wl + W_1), M, DFF, D, D, D}; pg8::StaticOrder S; S.init(M, DFF, G, bx);
                pg8::EpiBf16<1> E{HB, DFF, AIN(I_B1) + l * DFF};
                pg8::gemm_phase(lds, tid, g, S, E);
            } else {
                if (l + 1 < DEPTH) ln_pass<1>(outp, outp, UB, AIN(I_LFG) + l * D, AIN(I_LFB) + l * D, modl + 8 * 6144 + 1 * D, modl + 8 * 6144 + 0 * D, gw, ngw, lane);
                else ln_pass<2>(outp, outp, nullptr, AIN(I_LFG) + l * D, AIN(I_LFB) + l * D, nullptr, nullptr, gw, ngw, lane);
            }
        }
    }
}

extern "C" void kernel_launch(void* const* d_in, const int* in_sizes, int n_in, void* d_out, int out_size, void* d_ws, size_t ws_size, hipStream_t stream) {
    static int grid = 0;
    if (grid == 0) {
        if (n_in != 25 || in_sizes[0] != M * D || out_size != M * D || ws_size < WS_END) {
            fprintf(stderr, "kernel_launch: unexpected shapes: n_in %d in0 %d out %d ws %zu (need %zu); nothing launched\n", n_in, n_in > 0 ? in_sizes[0] : -1, out_size, ws_size, (size_t)WS_END); grid = -1; return; }
        int dev = 0, cus = 0, per_cu = 0;
        if (hipGetDevice(&dev) != hipSuccess || hipDeviceGetAttribute(&cus, hipDeviceAttributeMultiprocessorCount, dev) != hipSuccess) { grid = -1; return; }
        if (hipFuncSetAttribute((const void*)fwd, hipFuncAttributeMaxDynamicSharedMemorySize, LDS_BYTES) != hipSuccess) { fprintf(stderr, "kernel_launch: hipFuncSetAttribute failed\n"); grid = -1; return; }
        if (hipOccupancyMaxActiveBlocksPerMultiprocessor(&per_cu, (const void*)fwd, 512, LDS_BYTES) != hipSuccess || per_cu < 1) { fprintf(stderr, "kernel_launch: occupancy query says %d blocks per CU\n", per_cu); (void)hipGetLastError(); grid = -1; return; }
        grid = cus;
    }
    if (grid < 0) return;
    Args a{};
    for (int i = 0; i < 25; ++i) a.in[i] = (const float*)d_in[i];
    a.out = (float*)d_out; a.ws = (unsigned char*)d_ws;
#if MK_ONE_LAUNCH
    a.ph_lo = 0; a.ph_hi = NPH;
    void* args[] = {&a};
    hipError_t e = hipLaunchCooperativeKernel((const void*)fwd, dim3(grid), dim3(512), args, LDS_BYTES, stream);
    if (e != hipSuccess) fprintf(stderr, "cooperative launch failed: %s (grid %d)\n", hipGetErrorString(e), grid);
#else
    for (int ph = 0; ph < NPH; ++ph) { a.ph_lo = ph; a.ph_hi = ph + 1; hipLaunchKernelGGL(fwd, dim3(grid), dim3(512), LDS_BYTES, stream, a); }
#endif
}
```

```cpp
#include <hip/hip_runtime.h>
#include <hip/hip_cooperative_groups.h>
#include <cstdio>
#include <cstdint>
namespace cg = cooperative_groups;

#ifndef MK_ONE_LAUNCH
#define MK_ONE_LAUNCH 1
#endif

#define LAS __attribute__((address_space(3)))
typedef unsigned short bf16_t;
typedef short bf16x8 __attribute__((ext_vector_type(8)));
typedef float f32x4 __attribute__((ext_vector_type(4)));
typedef float f32x16 __attribute__((ext_vector_type(16)));
typedef unsigned u32x4 __attribute__((ext_vector_type(4)));
typedef unsigned u32x2 __attribute__((ext_vector_type(2)));

constexpr int M = 32768, D = 1024, SEQ = 4096, DFF = 4096, DEPTH = 2;
constexpr int ZM_LD = 1792, ZG_LD = 3072;
constexpr int NWIN = 4864;
constexpr float ALPHA = 1.4142135623730951f;
constexpr float LN_EPS = 1e-5f;
constexpr float LOG2E = 1.4426950408889634f;
constexpr float QSCALE = 0.125f * LOG2E;

constexpr size_t MiB = 1u << 20;
constexpr size_t WS_MOD = 1 * MiB;
constexpr size_t WS_W = 2 * MiB, WS_WL = 31 * MiB;
constexpr size_t W_IN = 0, W_V = 9 * MiB + MiB / 2, W_BP = 10 * MiB + MiB / 2, W_BA = 11 * MiB, W_BC = 12 * MiB, W_O = 12 * MiB + MiB / 2, W_1 = 14 * MiB + MiB / 2, W_2 = 22 * MiB + MiB / 2;
constexpr size_t WS_UB = 64 * MiB;
constexpr size_t WS_ZM = 128 * MiB;
constexpr size_t WS_VT = 240 * MiB;
constexpr size_t WS_ZG = 272 * MiB;
constexpr size_t WS_H = 128 * MiB;
constexpr size_t WS_MG = 128 * MiB;
constexpr size_t WS_END = 464 * MiB;

constexpr int LDS_BYTES = 147456;
constexpr int NPH = 2 + 8 * DEPTH;

typedef float f32x2_t __attribute__((ext_vector_type(2))); typedef __bf16 bf16x2_t __attribute__((ext_vector_type(2)));
__device__ __forceinline__ unsigned cvt_pk_bf16(float lo, float hi) { f32x2_t v = {lo, hi}; bf16x2_t b = __builtin_convertvector(v, bf16x2_t); return __builtin_bit_cast(unsigned, b); }
__device__ __forceinline__ float bf_lo(unsigned u) { return __uint_as_float(u << 16); }
__device__ __forceinline__ float bf_hi(unsigned u) { return __uint_as_float(u & 0xffff0000u); }
__device__ __forceinline__ float sigmoid_f(float x) { return __builtin_amdgcn_rcpf(1.f + __builtin_amdgcn_exp2f(-LOG2E * x)); }
__device__ __forceinline__ unsigned f2bf(float f) { unsigned u = __builtin_bit_cast(unsigned, f); return (u + 0x7fffu + ((u >> 16) & 1u)) >> 16; }
__device__ __forceinline__ float wave_sum(float v) {
#pragma unroll
    for (int o = 1; o < 64; o <<= 1) v += __shfl_xor(v, o);
    return v;
}
#define LDS_WAIT() asm volatile("s_waitcnt lgkmcnt(0)" ::: "memory")

namespace pg8 {
constexpr int BM = 256, BK = 64, HALF = 128, HTB = HALF * BK * 2, STAGE_BYTES = 8 * HTB, NXCD = 8, WGM = 8;
__host__ __device__ __forceinline__ int lds_byte(int r, int c) { const int st = (r >> 4) * 2 + (c >> 5), rr = r & 15, cc = c & 31, ob = rr * 64 + cc * 2; return st * 1024 + (ob ^ (((ob >> 9) & 1) << 5)); }
__host__ __device__ __forceinline__ void stage_rc(int b, int& R, int& C) { const int st = b / 1024, sb = b % 1024, swz = sb ^ (((sb >> 9) & 1) << 5); R = (st >> 1) * 16 + swz / 64; C = (st & 1) * 32 + (swz % 64) / 2; }
__host__ __device__ __forceinline__ int perm32(int rho) { const int n = rho >> 4, i = rho & 15; return 8 * (i >> 2) + 4 * n + (i & 3); }

struct Unit { int pm, pn; };
struct Gemm { const bf16_t* A; const bf16_t* Bt; int M, N, K, lda, ldb; };

struct StaticOrder {
    int nM, nN, nwg, G, c;
    __host__ __device__ void init(int M_, int N_, int G_, int c_) { nM = M_ / BM; nN = N_ / BM; nwg = nM * nN; G = G_; c = c_; }
    __host__ __device__ bool next(int i, Unit& u) const {
        const long L = (long)i * G + c; if (L >= nwg) return false;
        int wgid = (int)L; { const int q = nwg / NXCD, r = nwg % NXCD, xcd = wgid % NXCD, off = wgid / NXCD; wgid = (xcd < r ? xcd * (q + 1) : r * (q + 1) + (xcd - r) * q) + off; }
        const int nig = WGM * nN, gid = wgid / nig, fm = gid * WGM, gsz = (nM - fm) < WGM ? (nM - fm) : WGM;
        u.pm = fm + ((wgid % nig) % gsz); u.pn = (wgid % nig) / gsz; return true;
    }
};

typedef f32x4 Acc[2][2][4][2];

template <class Epi>
__device__ __forceinline__ void gemm_phase(LAS unsigned char* lds, const int tid, const Gemm g, const StaticOrder& S, const Epi& E) {
    const int wid = __builtin_amdgcn_readfirstlane(tid >> 6), lane = tid & 63, wr = wid >> 2, wc = wid & 3, fr = lane & 15, fq = lane >> 4;
    const int K = g.K, nt = K / BK;
    unsigned voffA[2], voffB[2];
#pragma unroll
    for (int i = 0; i < 2; ++i) { int R, C; stage_rc(tid * 16 + i * 8192, R, C); const int Rb = Epi::PERM ? ((R & ~31) + perm32(R & 31)) : R;
        voffA[i] = (unsigned)(R * g.lda + C) * 2u; voffB[i] = (unsigned)(Rb * g.ldb + C) * 2u; }
    const size_t kstep = (size_t)(BK * 2);
    const size_t hA = (size_t)HALF * g.lda * 2, hB = (size_t)HALF * g.ldb * 2;
    const size_t tA = 2 * hA, tB = 2 * hB;
    const unsigned ldsw = (unsigned)wid * 1024u;
    const int aoff = lds_byte(wr * 64 + fr, fq * 8), boff = lds_byte(wc * 32 + fr, fq * 8);
#define PG8_SA(b, h) (((b) * 2 + (h)) * HTB)
#define PG8_SB(b, h) ((4 + (b) * 2 + (h)) * HTB)
#define PG8_STAGE(bufoff, gbase, voff) do { _Pragma("unroll") for (int _i = 0; _i < 2; ++_i) \
        __builtin_amdgcn_global_load_lds((const unsigned*)((const char*)(gbase) + (voff)[_i]), (LAS unsigned*)(lds + (bufoff) + ldsw + _i * 8192), 16, 0, 0); } while (0)
#define PG8_LDA(dst, b, h) do { _Pragma("unroll") for (int m = 0; m < 4; ++m) _Pragma("unroll") for (int k = 0; k < 2; ++k) dst[m][k] = *(const LAS bf16x8*)(lds + PG8_SA(b, h) + aoff + m * 2048 + k * 1024); } while (0)
#define PG8_LDB(dst, b, h) do { _Pragma("unroll") for (int n = 0; n < 2; ++n) _Pragma("unroll") for (int k = 0; k < 2; ++k) dst[n][k] = *(const LAS bf16x8*)(lds + PG8_SB(b, h) + boff + n * 2048 + k * 1024); } while (0)
#define PG8_MMA(ai, bj, At, Bt) do { __builtin_amdgcn_s_setprio(1); _Pragma("unroll") for (int m = 0; m < 4; ++m) _Pragma("unroll") for (int n = 0; n < 2; ++n) _Pragma("unroll") for (int k = 0; k < 2; ++k) \
        acc[ai][bj][m][n] = __builtin_amdgcn_mfma_f32_16x16x32_bf16(Bt[n][k], At[m][k], acc[ai][bj][m][n], 0, 0, 0); __builtin_amdgcn_s_setprio(0); } while (0)
#define PG8_WAIT_V(n) asm volatile("s_waitcnt vmcnt(" #n ")" ::: "memory")
#define PG8_WAIT_L(n) asm volatile("s_waitcnt lgkmcnt(" #n ")" ::: "memory")
#define PG8_BAR __builtin_amdgcn_s_barrier()
#define PG8_SCHED __builtin_amdgcn_sched_barrier(0)
    Unit cur, nxt; int ui = 0;
    if (!S.next(0, cur)) return;
    Acc acc;
#pragma unroll
    for (int a = 0; a < 2; ++a)
#pragma unroll
        for (int b = 0; b < 2; ++b)
#pragma unroll
            for (int m = 0; m < 4; ++m)
#pragma unroll
                for (int n = 0; n < 2; ++n) acc[a][b][m][n] = (f32x4){0.f, 0.f, 0.f, 0.f};
    bf16x8 At[4][2], B0[2][2], B1[2][2];
    const char* cA = (const char*)g.A + (size_t)cur.pm * tA; const char* cB = (const char*)g.Bt + (size_t)cur.pn * tB;
    PG8_STAGE(PG8_SB(0, 0), cB, voffB); PG8_STAGE(PG8_SB(0, 1), cB + hB, voffB); PG8_STAGE(PG8_SA(0, 0), cA, voffA); PG8_STAGE(PG8_SA(0, 1), cA + hA, voffA);
    if (wr == 1) PG8_BAR;
    PG8_WAIT_V(2); PG8_BAR;
    PG8_STAGE(PG8_SB(1, 0), cB + kstep, voffB); PG8_STAGE(PG8_SA(1, 0), cA + kstep, voffA); PG8_STAGE(PG8_SB(1, 1), cB + hB + kstep, voffB);
    PG8_WAIT_V(6); PG8_BAR;
    for (;;) {
        const bool has_next = S.next(ui + 1, nxt);
        const char* nA = has_next ? (const char*)g.A + (size_t)nxt.pm * tA : cA; const char* nB = has_next ? (const char*)g.Bt + (size_t)nxt.pn * tB : cB;
        for (int t = 0; t < nt; t += 2) {
            const bool last = (t == nt - 2);
            const char* a1 = cA + (size_t)(t + 1) * kstep;
            const char* a2 = last ? nA : cA + (size_t)(t + 2) * kstep; const char* b2 = last ? nB : cB + (size_t)(t + 2) * kstep;
            const char* a3 = a2 + kstep; const char* b3 = b2 + kstep;
            PG8_LDB(B0, 0, 0); PG8_LDB(B1, 0, 1); PG8_SCHED; PG8_LDA(At, 0, 0); PG8_STAGE(PG8_SA(1, 1), a1 + hA, voffA);
            PG8_WAIT_V(8); PG8_WAIT_L(0); PG8_BAR; PG8_MMA(0, 0, At, B0); PG8_MMA(0, 1, At, B1); PG8_BAR; PG8_SCHED;
            PG8_LDA(At, 0, 1); PG8_STAGE(PG8_SB(0, 0), b2, voffB); PG8_STAGE(PG8_SB(0, 1), b2 + hB, voffB); PG8_STAGE(PG8_SA(0, 0), a2, voffA);
            PG8_WAIT_V(8); PG8_WAIT_L(0); PG8_BAR; PG8_MMA(1, 0, At, B0); PG8_MMA(1, 1, At, B1); PG8_BAR; PG8_SCHED;
            PG8_LDB(B0, 1, 0); PG8_LDB(B1, 1, 1); PG8_SCHED; PG8_LDA(At, 1, 0); PG8_STAGE(PG8_SA(0, 1), a2 + hA, voffA);
            PG8_WAIT_V(8); PG8_WAIT_L(0); PG8_BAR; PG8_MMA(0, 0, At, B0); PG8_MMA(0, 1, At, B1); PG8_BAR; PG8_SCHED;
            PG8_LDA(At, 1, 1); PG8_STAGE(PG8_SB(1, 0), b3, voffB); PG8_STAGE(PG8_SB(1, 1), b3 + hB, voffB); PG8_STAGE(PG8_SA(1, 0), a3, voffA);
            PG8_WAIT_V(8); PG8_WAIT_L(0); PG8_BAR; PG8_MMA(1, 0, At, B0); PG8_MMA(1, 1, At, B1); PG8_BAR; PG8_SCHED;
        }
        if (wr == 0) PG8_BAR;
        E(acc, cur, wr, wc, fr, fq);
        if (!has_next) break;
#pragma unroll
        for (int a = 0; a < 2; ++a)
#pragma unroll
            for (int b = 0; b < 2; ++b)
#pragma unroll
                for (int m = 0; m < 4; ++m)
#pragma unroll
                    for (int n = 0; n < 2; ++n) acc[a][b][m][n] = (f32x4){0.f, 0.f, 0.f, 0.f};
        cur = nxt; cA = nA; cB = nB; ++ui;
        if (wr == 1) PG8_BAR;
    }
    PG8_WAIT_V(0);
    PG8_BAR;
#undef PG8_SA
#undef PG8_SB
#undef PG8_STAGE
#undef PG8_LDA
#undef PG8_LDB
#undef PG8_MMA
#undef PG8_WAIT_V
#undef PG8_WAIT_L
#undef PG8_BAR
#undef PG8_SCHED
}

struct EpiZ {
    static constexpr bool PERM = true;
    bf16_t* zm; bf16_t* zg; const float* bgate;
    __device__ __forceinline__ void operator()(const Acc& acc, const Unit& u, int wr, int wc, int fr, int fq) const {
        const int row0 = u.pm * BM + wr * 64 + fr;
        if (u.pn < 7) {
            const float sc = (u.pn == 1 || u.pn == 2) ? QSCALE : 1.f;
            const int col0 = u.pn * BM + wc * 32 + 8 * fq;
#pragma unroll
            for (int ai = 0; ai < 2; ++ai)
#pragma unroll
                for (int m = 0; m < 4; ++m) { bf16_t* rowp = zm + (size_t)(row0 + ai * HALF + m * 16) * ZM_LD + col0;
#pragma unroll
                    for (int bj = 0; bj < 2; ++bj) { const f32x4 v0 = acc[ai][bj][m][0] * sc, v1 = acc[ai][bj][m][1] * sc;
                        u32x4 w; w.x = cvt_pk_bf16(v0[0], v0[1]); w.y = cvt_pk_bf16(v0[2], v0[3]); w.z = cvt_pk_bf16(v1[0], v1[1]); w.w = cvt_pk_bf16(v1[2], v1[3]);
                        *(u32x4*)(rowp + bj * HALF) = w; } }
        } else {
            const int col0 = (u.pn - 7) * BM + wc * 32 + 8 * fq;
            f32x4 bv[2][2];
#pragma unroll
            for (int bj = 0; bj < 2; ++bj)
#pragma unroll
                for (int n = 0; n < 2; ++n) bv[bj][n] = *(const f32x4*)(bgate + col0 + bj * HALF + 4 * n);
#pragma unroll
            for (int ai = 0; ai < 2; ++ai)
#pragma unroll
                for (int m = 0; m < 4; ++m) { bf16_t* rowp = zg + (size_t)(row0 + ai * HALF + m * 16) * ZG_LD + col0;
#pragma unroll
                    for (int bj = 0; bj < 2; ++bj) { f32x4 v0 = acc[ai][bj][m][0] + bv[bj][0], v1 = acc[ai][bj][m][1] + bv[bj][1];
#pragma unroll
                        for (int e = 0; e < 4; ++e) { v0[e] = sigmoid_f(v0[e]); v1[e] = sigmoid_f(v1[e]); }
                        u32x4 w; w.x = cvt_pk_bf16(v0[0], v0[1]); w.y = cvt_pk_bf16(v0[2], v0[3]); w.z = cvt_pk_bf16(v1[0], v1[1]); w.w = cvt_pk_bf16(v1[2], v1[3]);
                        *(u32x4*)(rowp + bj * HALF) = w; } }
        }
    }
};
template <int ACT> struct EpiBf16 {
    static constexpr bool PERM = true;
    bf16_t* O; int ldc; const float* bias;
    __device__ __forceinline__ void operator()(const Acc& acc, const Unit& u, int wr, int wc, int fr, int fq) const {
        const int row0 = u.pm * BM + wr * 64 + fr, col0 = u.pn * BM + wc * 32 + 8 * fq;
        f32x4 bv[2][2];
#pragma unroll
        for (int bj = 0; bj < 2; ++bj)
#pragma unroll
            for (int n = 0; n < 2; ++n) bv[bj][n] = ACT ? *(const f32x4*)(bias + col0 + bj * HALF + 4 * n) : (f32x4){0.f, 0.f, 0.f, 0.f};
#pragma unroll
        for (int ai = 0; ai < 2; ++ai)
#pragma unroll
            for (int m = 0; m < 4; ++m) { bf16_t* rowp = O + (size_t)(row0 + ai * HALF + m * 16) * ldc + col0;
#pragma unroll
                for (int bj = 0; bj < 2; ++bj) { f32x4 v0 = acc[ai][bj][m][0] + bv[bj][0], v1 = acc[ai][bj][m][1] + bv[bj][1];
                    if (ACT) {
#pragma unroll
                        for (int e = 0; e < 4; ++e) { const float a = fmaxf(v0[e], 0.f), b = fmaxf(v1[e], 0.f); v0[e] = a * a; v1[e] = b * b; } }
                    u32x4 w; w.x = cvt_pk_bf16(v0[0], v0[1]); w.y = cvt_pk_bf16(v0[2], v0[3]); w.z = cvt_pk_bf16(v1[0], v1[1]); w.w = cvt_pk_bf16(v1[2], v1[3]);
                    *(u32x4*)(rowp + bj * HALF) = w; } }
    }
};
struct EpiGate {
    static constexpr bool PERM = true;
    bf16_t* mg; const bf16_t* zg; int first;
    __device__ __forceinline__ void operator()(const Acc& acc, const Unit& u, int wr, int wc, int fr, int fq) const {
        const int row0 = u.pm * BM + wr * 64 + fr, col0 = u.pn * BM + wc * 32 + 8 * fq;
#pragma unroll
        for (int ai = 0; ai < 2; ++ai)
#pragma unroll
            for (int m = 0; m < 4; ++m) { const size_t r = (size_t)(row0 + ai * HALF + m * 16);
#pragma unroll
                for (int bj = 0; bj < 2; ++bj) {
                    const u32x4 gv = *(const u32x4*)(zg + r * ZG_LD + col0 + bj * HALF);
                    bf16_t* mp = mg + r * D + col0 + bj * HALF;
                    u32x4 ov = (u32x4){0u, 0u, 0u, 0u}; if (!first) ov = *(const u32x4*)mp;
                    const f32x4 a0 = acc[ai][bj][m][0], a1 = acc[ai][bj][m][1];
                    u32x4 w;
                    w.x = cvt_pk_bf16(bf_lo(ov.x) + bf_lo(gv.x) * a0[0], bf_hi(ov.x) + bf_hi(gv.x) * a0[1]);
                    w.y = cvt_pk_bf16(bf_lo(ov.y) + bf_lo(gv.y) * a0[2], bf_hi(ov.y) + bf_hi(gv.y) * a0[3]);
                    w.z = cvt_pk_bf16(bf_lo(ov.z) + bf_lo(gv.z) * a1[0], bf_hi(ov.z) + bf_hi(gv.z) * a1[1]);
                    w.w = cvt_pk_bf16(bf_lo(ov.w) + bf_lo(gv.w) * a1[2], bf_hi(ov.w) + bf_hi(gv.w) * a1[3]);
                    *(u32x4*)mp = w; } }
    }
};
struct EpiRes {
    static constexpr bool PERM = false;
    const float* xin; float* out; const float* gvec; const float* bias;
    __device__ __forceinline__ void operator()(const Acc& acc, const Unit& u, int wr, int wc, int fr, int fq) const {
        const int row0 = u.pm * BM + wr * 64 + fr, col0 = u.pn * BM + wc * 32 + 4 * fq;
        const float* gp = gvec + (size_t)(u.pm >> 4) * 6144;
#pragma unroll
        for (int bj = 0; bj < 2; ++bj)
#pragma unroll
            for (int n = 0; n < 2; ++n) { const int col = col0 + bj * HALF + n * 16;
                const f32x4 gv = *(const f32x4*)(gp + col); const f32x4 bv = bias ? *(const f32x4*)(bias + col) : (f32x4){0.f, 0.f, 0.f, 0.f};
#pragma unroll
                for (int ai = 0; ai < 2; ++ai)
#pragma unroll
                    for (int m = 0; m < 4; ++m) { const size_t off = (size_t)(row0 + ai * HALF + m * 16) * D + col;
                        const f32x4 xv = *(const f32x4*)(xin + off);
                        *(f32x4*)(out + off) = xv * ALPHA + gv * (acc[ai][bj][m][n] + bv); } }
    }
};
}

struct Args { const float* in[25]; float* out; unsigned char* ws; int ph_lo, ph_hi; };
enum { I_X = 0, I_C, I_WADA, I_BADA, I_WIN, I_BGATE, I_WPOOL, I_PSCALE, I_RELB, I_CONVW, I_CONVB, I_CLNG, I_CLNB, I_WBP, I_WBA, I_WBC, I_WO, I_LMG, I_LMB, I_W1, I_B1, I_W2, I_B2, I_LFG, I_LFB };

__device__ __forceinline__ void tr_item(const float* W, int N, int k0, int n0, bf16_t* dst, int dK, LAS float* scr, int lane) {
    float tv[32];
#pragma unroll
    for (int i = 0; i < 32; ++i) tv[i] = W[(size_t)(k0 + 2 * i + (lane >> 5)) * N + n0 + (lane & 31)];
#pragma unroll
    for (int i = 0; i < 32; ++i) scr[(2 * i + (lane >> 5)) * 33 + (lane & 31)] = tv[i];
    LDS_WAIT();
    const int c = lane & 7;
#pragma unroll
    for (int j = 0; j < 4; ++j) { const int n = (lane >> 3) + 8 * j; const LAS float* s = scr + (8 * c) * 33 + n;
        u32x4 o; o.x = f2bf(s[0 * 33]) | (f2bf(s[1 * 33]) << 16); o.y = f2bf(s[2 * 33]) | (f2bf(s[3 * 33]) << 16); o.z = f2bf(s[4 * 33]) | (f2bf(s[5 * 33]) << 16); o.w = f2bf(s[6 * 33]) | (f2bf(s[7 * 33]) << 16);
        *(u32x4*)(dst + (size_t)n * dK + 8 * c) = o; }
    LDS_WAIT();
}

template <int MODE>
__device__ __forceinline__ void ln_pass(const float* src, float* dst, bf16_t* u, const float* g, const float* bb, const float* modsc, const float* modsh, int gw, int ngw, int lane) {
    for (int row0 = gw * 16; row0 < M; row0 += ngw * 16) {
        const int batch = row0 >> 12;
        f32x4 gv[4], bv[4], scv[4], shv[4];
#pragma unroll
        for (int j = 0; j < 4; ++j) {
            if (MODE >= 1) { gv[j] = *(const f32x4*)(g + 4 * lane + 256 * j); bv[j] = *(const f32x4*)(bb + 4 * lane + 256 * j); }
            if (MODE != 2) { scv[j] = *(const f32x4*)(modsc + (size_t)batch * 6144 + 4 * lane + 256 * j) + 1.f; shv[j] = *(const f32x4*)(modsh + (size_t)batch * 6144 + 4 * lane + 256 * j); }
        }
        f32x4 nv[4], nw[4];
#pragma unroll
        for (int j = 0; j < 4; ++j) { nv[j] = *(const f32x4*)(src + (size_t)row0 * D + 4 * lane + 256 * j); nw[j] = *(const f32x4*)(src + (size_t)(row0 + 1) * D + 4 * lane + 256 * j); }
        for (int r = 0; r < 16; ++r) {
            const size_t off = (size_t)(row0 + r) * D + 4 * lane;
            f32x4 v[4];
#pragma unroll
            for (int j = 0; j < 4; ++j) { v[j] = nv[j]; nv[j] = nw[j]; }
            if (r < 14) {
#pragma unroll
                for (int j = 0; j < 4; ++j) nw[j] = *(const f32x4*)(src + off + 2 * D + 256 * j);
            }
            float s = 0.f;
#pragma unroll
            for (int j = 0; j < 4; ++j) s += (v[j].x + v[j].y) + (v[j].z + v[j].w);
            float mean = wave_sum(s) * (1.f / D), s2 = 0.f;
#pragma unroll
            for (int j = 0; j < 4; ++j) { v[j] = v[j] - mean; s2 += (v[j].x * v[j].x + v[j].y * v[j].y) + (v[j].z * v[j].z + v[j].w * v[j].w); }
            float rstd = 1.f / sqrtf(wave_sum(s2) * (1.f / D) + LN_EPS);
            if (MODE >= 1) {
                s = 0.f;
#pragma unroll
                for (int j = 0; j < 4; ++j) { v[j] = v[j] * rstd * gv[j] + bv[j]; *(f32x4*)(dst + off + 256 * j) = v[j]; s += (v[j].x + v[j].y) + (v[j].z + v[j].w); }
                if (MODE == 1) {
                    mean = wave_sum(s) * (1.f / D); s2 = 0.f;
#pragma unroll
                    for (int j = 0; j < 4; ++j) { v[j] = v[j] - mean; s2 += (v[j].x * v[j].x + v[j].y * v[j].y) + (v[j].z * v[j].z + v[j].w * v[j].w); }
                    rstd = 1.f / sqrtf(wave_sum(s2) * (1.f / D) + LN_EPS);
                }
            }
            if (MODE != 2) {
#pragma unroll
                for (int j = 0; j < 4; ++j) { const f32x4 o = v[j] * rstd * scv[j] + shv[j]; u32x2 w; w.x = cvt_pk_bf16(o.x, o.y); w.y = cvt_pk_bf16(o.z, o.w); *(u32x2*)(u + off + 256 * j) = w; }
            }
        }
    }
}

__device__ __forceinline__ void attn_wave(const bf16_t* zm, const bf16_t* vt, bf16_t* bcat, const LAS float* rb  , int b, int n, int h, int qh, int lane) {
    const int r32 = lane & 31, hi = lane >> 5;
    const size_t tok0 = (size_t)b * SEQ + (size_t)n * 64;
    const bf16_t* qp = zm + (tok0 + qh * 32 + r32) * ZM_LD + 256 + h * 64 + hi * 8;
    bf16x8 qf[4];
#pragma unroll
    for (int d0 = 0; d0 < 4; ++d0) qf[d0] = *(const bf16x8*)(qp + d0 * 16);
    const int pi = (r32 & ~12) | ((r32 & 4) << 1) | ((r32 & 8) >> 1);
    float m_run = -1e30f, l_run = 0.f;
    f32x16 o[2];
#pragma unroll
    for (int r = 0; r < 16; ++r) { o[0][r] = 0.f; o[1][r] = 0.f; }
    const int qi = qh * 32 + r32;
    const int jlo = n < 8 ? 8 - n : 0;
    bf16x8 kf[2][4];
    {   const size_t kt0 = tok0 - (size_t)(8 - jlo) * 64;
#pragma unroll
        for (int kb = 0; kb < 2; ++kb) { const bf16_t* kp = zm + (kt0 + kb * 32 + pi) * ZM_LD + 768 + h * 64 + hi * 8;
#pragma unroll
            for (int d0 = 0; d0 < 4; ++d0) kf[kb][d0] = *(const bf16x8*)(kp + d0 * 16); } }
    for (int j = jlo; j <= 8; ++j) {
        const int delta = 8 - j;
        const size_t kt0 = tok0 - (size_t)delta * 64;
        bf16x8 vf[2][4], kn[2][4];
#pragma unroll
        for (int db = 0; db < 2; ++db) { const bf16_t* vp = vt + (size_t)(h * 64 + db * 32 + r32) * M + kt0 + hi * 8;
#pragma unroll
            for (int c = 0; c < 4; ++c) vf[db][c] = *(const bf16x8*)(vp + c * 16); }
        {   const size_t kt1 = kt0 + (j < 8 ? 64 : 0);
#pragma unroll
            for (int kb = 0; kb < 2; ++kb) { const bf16_t* kp = zm + (kt1 + kb * 32 + pi) * ZM_LD + 768 + h * 64 + hi * 8;
#pragma unroll
                for (int d0 = 0; d0 < 4; ++d0) kn[kb][d0] = *(const bf16x8*)(kp + d0 * 16); } }
        f32x16 s[2];
#pragma unroll
        for (int kb = 0; kb < 2; ++kb) {
#pragma unroll
            for (int r = 0; r < 16; ++r) s[kb][r] = 0.f;
#pragma unroll
            for (int d0 = 0; d0 < 4; ++d0) s[kb] = __builtin_amdgcn_mfma_f32_32x32x16_bf16(kf[kb][d0], qf[d0], s[kb], 0, 0, 0);
        }
        if (delta >= 3) {
            const float cb = rb[256];
#pragma unroll
            for (int kb = 0; kb < 2; ++kb)
#pragma unroll
                for (int r = 0; r < 16; ++r) s[kb][r] += cb;
        } else {
            const int base = delta * 64 + qi - 8 * hi;
#pragma unroll
            for (int kb = 0; kb < 2; ++kb)
#pragma unroll
                for (int r = 0; r < 16; ++r) { int dd = base - (kb * 32 + 16 * (r >> 3) + (r & 7)); dd = dd > 128 ? 128 : dd; s[kb][r] += rb[dd + 128]; }
        }
        float mx = s[0][0];
#pragma unroll
        for (int kb = 0; kb < 2; ++kb)
#pragma unroll
            for (int r = 0; r < 16; ++r) mx = fmaxf(mx, s[kb][r]);
        mx = fmaxf(mx, __shfl_xor(mx, 32));
        const float m_new = fmaxf(m_run, mx);
        const float f = __builtin_amdgcn_exp2f(m_run - m_new);
        m_run = m_new;
        float ps = 0.f;
#pragma unroll
        for (int kb = 0; kb < 2; ++kb)
#pragma unroll
            for (int r = 0; r < 16; ++r) { s[kb][r] = __builtin_amdgcn_exp2f(s[kb][r] - m_new); ps += s[kb][r]; }
        l_run = l_run * f + ps;
#pragma unroll
        for (int r = 0; r < 16; ++r) { o[0][r] *= f; o[1][r] *= f; }
        bf16x8 pf[4];
#pragma unroll
        for (int c = 0; c < 4; ++c) { const int kb = c >> 1, s8 = (c & 1) * 8; u32x4 w;
            w.x = cvt_pk_bf16(s[kb][s8 + 0], s[kb][s8 + 1]); w.y = cvt_pk_bf16(s[kb][s8 + 2], s[kb][s8 + 3]); w.z = cvt_pk_bf16(s[kb][s8 + 4], s[kb][s8 + 5]); w.w = cvt_pk_bf16(s[kb][s8 + 6], s[kb][s8 + 7]);
            pf[c] = __builtin_bit_cast(bf16x8, w); }
#pragma unroll
        for (int db = 0; db < 2; ++db)
#pragma unroll
            for (int c = 0; c < 4; ++c) o[db] = __builtin_amdgcn_mfma_f32_32x32x16_bf16(vf[db][c], pf[c], o[db], 0, 0, 0);
#pragma unroll
        for (int kb = 0; kb < 2; ++kb)
#pragma unroll
            for (int d0 = 0; d0 < 4; ++d0) kf[kb][d0] = kn[kb][d0];
    }
    const float l = l_run + __shfl_xor(l_run, 32);
    const float inv = 1.f / l;
    bf16_t* op = bcat + (tok0 + qh * 32 + r32) * D + 256 + h * 64 + 4 * hi;
#pragma unroll
    for (int db = 0; db < 2; ++db)
#pragma unroll
        for (int g4 = 0; g4 < 4; ++g4) { u32x2 w; w.x = cvt_pk_bf16(o[db][4 * g4 + 0] * inv, o[db][4 * g4 + 1] * inv); w.y = cvt_pk_bf16(o[db][4 * g4 + 2] * inv, o[db][4 * g4 + 3] * inv);
            *(u32x2*)(op + db * 32 + 8 * g4) = w; }
}


__device__ __forceinline__ void attn_wave2(const bf16_t* zm, const bf16_t* vt, bf16_t* bcat, const LAS float* rb, LAS unsigned char* wl, int b, int n, int h, int lane) {
    const int r32 = lane & 31, hi = lane >> 5;
    const size_t tok0 = (size_t)b * SEQ + (size_t)n * 64;
    bf16x8 qf[2][4];
#pragma unroll
    for (int qh = 0; qh < 2; ++qh)
#pragma unroll
        for (int d0 = 0; d0 < 4; ++d0) qf[qh][d0] = *(const bf16x8*)(zm + (tok0 + qh * 32 + r32) * ZM_LD + 256 + h * 64 + hi * 8 + d0 * 16);
    const int drow = lane >> 3, dch = (lane & 7) ^ drow;
    const bf16_t* ksrc = zm + (size_t)((drow & 3) + ((drow >> 2) << 3)) * ZM_LD + 768 + h * 64 + dch * 8;
    const bf16_t* vsrc = vt + (size_t)(h * 64 + drow) * M + dch * 8;
    const int kfo = r32 * 128, sw = r32 & 7;
    float m_run[2] = {-1e30f, -1e30f}, l_run[2] = {0.f, 0.f};
    f32x16 o[2][2];
#pragma unroll
    for (int r = 0; r < 16; ++r) { o[0][0][r] = 0.f; o[0][1][r] = 0.f; o[1][0][r] = 0.f; o[1][1][r] = 0.f; }
    const int jlo = n < 8 ? 8 - n : 0;
#define ATT_DMA_K(kt) do { _Pragma("unroll") for (int _i = 0; _i < 8; ++_i) __builtin_amdgcn_global_load_lds((const unsigned*)(ksrc + ((kt) + (size_t)(((_i & 1) << 2) + (((_i >> 1) & 1) << 4) + ((_i >> 2) << 5))) * ZM_LD), (LAS unsigned*)(wl + _i * 1024), 16, 0, 0); } while (0)
#define ATT_DMA_V(kt) do { _Pragma("unroll") for (int _i = 0; _i < 8; ++_i) __builtin_amdgcn_global_load_lds((const unsigned*)(vsrc + (size_t)(8 * _i) * M + (kt)), (LAS unsigned*)(wl + 8192 + _i * 1024), 16, 0, 0); } while (0)
    { const size_t kt0 = tok0 - (size_t)(8 - jlo) * 64; ATT_DMA_K(kt0); ATT_DMA_V(kt0); }
    for (int j = jlo; j <= 8; ++j) {
        const int delta = 8 - j; const bool last = (j == 8);
        const size_t kt0 = tok0 - (size_t)delta * 64;
        asm volatile("s_waitcnt vmcnt(8)" ::: "memory");
        bf16x8 pf[2][4];
#pragma unroll
        for (int qh = 0; qh < 2; ++qh) {
            f32x16 s[2];
#pragma unroll
            for (int kb = 0; kb < 2; ++kb) {
#pragma unroll
                for (int r = 0; r < 16; ++r) s[kb][r] = 0.f;
#pragma unroll
                for (int d0 = 0; d0 < 4; ++d0) { const bf16x8 kfr = *(const LAS bf16x8*)(wl + kb * 4096 + kfo + (((2 * d0 + hi) ^ sw) * 16));
                    s[kb] = __builtin_amdgcn_mfma_f32_32x32x16_bf16(kfr, qf[qh][d0], s[kb], 0, 0, 0); }
            }
            if (qh == 1 && !last) { asm volatile("s_waitcnt lgkmcnt(0)" ::: "memory"); ATT_DMA_K(kt0 + 64); }
            const int qi = qh * 32 + r32;
            if (delta >= 3) {
                const float cb = rb[256];
#pragma unroll
                for (int kb = 0; kb < 2; ++kb)
#pragma unroll
                    for (int r = 0; r < 16; ++r) s[kb][r] += cb;
            } else {
                const int base = delta * 64 + qi - 8 * hi;
#pragma unroll
                for (int kb = 0; kb < 2; ++kb)
#pragma unroll
                    for (int r = 0; r < 16; ++r) { int dd = base - (kb * 32 + 16 * (r >> 3) + (r & 7)); dd = dd > 128 ? 128 : dd; s[kb][r] += rb[dd + 128]; }
            }
            float mx = s[0][0];
#pragma unroll
            for (int kb = 0; kb < 2; ++kb)
#pragma unroll
                for (int r = 0; r < 16; ++r) mx = fmaxf(mx, s[kb][r]);
            mx = fmaxf(mx, __shfl_xor(mx, 32));
            const float m_new = fmaxf(m_run[qh], mx);
            const float f = __builtin_amdgcn_exp2f(m_run[qh] - m_new);
            m_run[qh] = m_new;
            float ps = 0.f;
#pragma unroll
            for (int kb = 0; kb < 2; ++kb)
#pragma unroll
                for (int r = 0; r < 16; ++r) { s[kb][r] = __builtin_amdgcn_exp2f(s[kb][r] - m_new); ps += s[kb][r]; }
            l_run[qh] = l_run[qh] * f + ps;
#pragma unroll
            for (int r = 0; r < 16; ++r) { o[qh][0][r] *= f; o[qh][1][r] *= f; }
#pragma unroll
            for (int c = 0; c < 4; ++c) { const int kb = c >> 1, s8 = (c & 1) * 8; u32x4 w;
                w.x = cvt_pk_bf16(s[kb][s8 + 0], s[kb][s8 + 1]); w.y = cvt_pk_bf16(s[kb][s8 + 2], s[kb][s8 + 3]); w.z = cvt_pk_bf16(s[kb][s8 + 4], s[kb][s8 + 5]); w.w = cvt_pk_bf16(s[kb][s8 + 6], s[kb][s8 + 7]);
                pf[qh][c] = __builtin_bit_cast(bf16x8, w); }
        }
        if (!last) asm volatile("s_waitcnt vmcnt(8)" ::: "memory"); else asm volatile("s_waitcnt vmcnt(0)" ::: "memory");
#pragma unroll
        for (int db = 0; db < 2; ++db)
#pragma unroll
            for (int c = 0; c < 4; ++c) { const bf16x8 vfr = *(const LAS bf16x8*)(wl + 8192 + db * 4096 + kfo + (((2 * c + hi) ^ sw) * 16));
                o[0][db] = __builtin_amdgcn_mfma_f32_32x32x16_bf16(vfr, pf[0][c], o[0][db], 0, 0, 0);
                o[1][db] = __builtin_amdgcn_mfma_f32_32x32x16_bf16(vfr, pf[1][c], o[1][db], 0, 0, 0); }
        if (!last) { asm volatile("s_waitcnt lgkmcnt(0)" ::: "memory"); ATT_DMA_V(kt0 + 64); }
    }
#undef ATT_DMA_K
#undef ATT_DMA_V
#pragma unroll
    for (int qh = 0; qh < 2; ++qh) {
        const float l = l_run[qh] + __shfl_xor(l_run[qh], 32);
        const float inv = 1.f / l;
        bf16_t* op = bcat + (tok0 + qh * 32 + r32) * D + 256 + h * 64 + 4 * hi;
#pragma unroll
        for (int db = 0; db < 2; ++db)
#pragma unroll
            for (int g4 = 0; g4 < 4; ++g4) { u32x2 w; w.x = cvt_pk_bf16(o[qh][db][4 * g4 + 0] * inv, o[qh][db][4 * g4 + 1] * inv); w.y = cvt_pk_bf16(o[qh][db][4 * g4 + 2] * inv, o[qh][db][4 * g4 + 3] * inv);
                *(u32x2*)(op + db * 32 + 8 * g4) = w; }
    }
}

template <int W>
__device__ __forceinline__ void pool_item(const bf16_t* zm, bf16_t* ub, int r, int c0) {
    const int t = r & (SEQ - 1), cnt = (t + 1) < W ? (t + 1) : W;
    const bf16_t* p = zm + (size_t)r * ZM_LD + c0;
    u32x4 v[W];
#pragma unroll
    for (int i = 0; i < W; ++i) { v[i] = (u32x4){0u, 0u, 0u, 0u}; if (i < cnt) v[i] = *(const u32x4*)(p - (size_t)i * ZM_LD); }
    float s[8];
#pragma unroll
    for (int e = 0; e < 8; ++e) s[e] = 0.f;
#pragma unroll
    for (int i = 0; i < W; ++i) { s[0] += bf_lo(v[i].x); s[1] += bf_hi(v[i].x); s[2] += bf_lo(v[i].y); s[3] += bf_hi(v[i].y); s[4] += bf_lo(v[i].z); s[5] += bf_hi(v[i].z); s[6] += bf_lo(v[i].w); s[7] += bf_hi(v[i].w); }
    const float inv = 1.f / (float)cnt;
    u32x4 o; o.x = cvt_pk_bf16(s[0] * inv - bf_lo(v[0].x), s[1] * inv - bf_hi(v[0].x)); o.y = cvt_pk_bf16(s[2] * inv - bf_lo(v[0].y), s[3] * inv - bf_hi(v[0].y));
    o.z = cvt_pk_bf16(s[4] * inv - bf_lo(v[0].z), s[5] * inv - bf_hi(v[0].z)); o.w = cvt_pk_bf16(s[6] * inv - bf_lo(v[0].w), s[7] * inv - bf_hi(v[0].w));
    *(u32x4*)(ub + (size_t)r * D + c0) = o;
}

__device__ __forceinline__ void conv_unit(LAS unsigned char* lds, const bf16_t* zm, bf16_t* bcat, const float* cw, const float* cb, const float* lg, const float* lb, int unit, int tid, int wave, int lane) {
    LAS float* hbuf = (LAS float*)(lds + 16384);
    LAS float* obuf = (LAS float*)(lds + 16384 + 62 * 256 * 4);
    const int b = unit >> 7, t0 = (unit & 127) * 32;
    for (int it = tid; it < 62 * 32; it += 512) {
        const int i = it >> 5, c8 = (it & 31) * 8, t = t0 - 30 + i;
        f32x4 h0 = (f32x4){0.f, 0.f, 0.f, 0.f}, h1 = h0;
        if (t >= 0) {
            const bf16_t* p = zm + ((size_t)b * SEQ + t) * ZM_LD + 1280 + c8;
            const u32x4 av = *(const u32x4*)p, gv = *(const u32x4*)(p + 256);
            h0 = (f32x4){bf_lo(av.x) * sigmoid_f(bf_lo(gv.x)), bf_hi(av.x) * sigmoid_f(bf_hi(gv.x)), bf_lo(av.y) * sigmoid_f(bf_lo(gv.y)), bf_hi(av.y) * sigmoid_f(bf_hi(gv.y))};
            h1 = (f32x4){bf_lo(av.z) * sigmoid_f(bf_lo(gv.z)), bf_hi(av.z) * sigmoid_f(bf_hi(gv.z)), bf_lo(av.w) * sigmoid_f(bf_lo(gv.w)), bf_hi(av.w) * sigmoid_f(bf_hi(gv.w))};
        }
        *(LAS f32x4*)(hbuf + i * 256 + c8) = h0; *(LAS f32x4*)(hbuf + i * 256 + c8 + 4) = h1;
    }
    __syncthreads();
    {
        const int c = tid & 255, th = tid >> 8;
        float w[31];
#pragma unroll
        for (int j = 0; j < 31; ++j) w[j] = cw[j * 256 + c];
        float acc[16]; const float bias = cb[c];
#pragma unroll
        for (int tt = 0; tt < 16; ++tt) acc[tt] = bias;
#pragma unroll
        for (int i = 0; i < 46; ++i) { const float hv = hbuf[(th * 16 + i) * 256 + c];
#pragma unroll
            for (int tt = 0; tt < 16; ++tt) { if (i - tt >= 0 && i - tt <= 30) acc[tt] += hv * w[i - tt]; } }
#pragma unroll
        for (int tt = 0; tt < 16; ++tt) obuf[(th * 16 + tt) * 256 + c] = acc[tt];
    }
    __syncthreads();
    {
        const f32x4 g4 = *(const f32x4*)(lg + 4 * lane), b4 = *(const f32x4*)(lb + 4 * lane);
#pragma unroll
        for (int k = 0; k < 4; ++k) { const int tok = wave * 4 + k;
            f32x4 v = *(const LAS f32x4*)(obuf + tok * 256 + 4 * lane);
            const float mean = wave_sum((v.x + v.y) + (v.z + v.w)) * (1.f / 256.f);
            v = v - mean;
            const float var = wave_sum((v.x * v.x + v.y * v.y) + (v.z * v.z + v.w * v.w)) * (1.f / 256.f);
            const float rstd = 1.f / sqrtf(var + LN_EPS);
            f32x4 y = v * rstd * g4 + b4;
#pragma unroll
            for (int e = 0; e < 4; ++e) y[e] = y[e] * sigmoid_f(y[e]);
            u32x2 wv; wv.x = cvt_pk_bf16(y.x, y.y); wv.y = cvt_pk_bf16(y.z, y.w);
            *(u32x2*)(bcat + ((size_t)b * SEQ + t0 + tok) * D + 768 + 4 * lane) = wv; }
    }
    __syncthreads();
}

__global__ void __launch_bounds__(512, 2) fwd(Args a) {
    extern __shared__ __attribute__((aligned(16))) unsigned char lds_raw[];
    LAS unsigned char* lds = (LAS unsigned char*)lds_raw;
    cg::grid_group grid = cg::this_grid();
    const int ph_lo = a.ph_lo, ph_hi = a.ph_hi;

    for (int ph = ph_lo; ph < ph_hi; ++ph) {
        if (ph > ph_lo) grid.sync();
        const __attribute__((address_space(4))) Args* ap = (const __attribute__((address_space(4))) Args*)__builtin_amdgcn_kernarg_segment_ptr();
        asm volatile("" : "+s"(ap));
        int tid = threadIdx.x; asm volatile("" : "+v"(tid));
        const int lane = tid & 63, wave = __builtin_amdgcn_readfirstlane(tid >> 6);
        const int G = gridDim.x, bx = blockIdx.x;
        const int vcu = (G % 8 == 0) ? (bx % 8) * (G / 8) + bx / 8 : bx;
        const int gw = vcu * 8 + wave, ngw = G * 8;
#define AIN(k) (ap->in[k])
        unsigned char* ws = ap->ws;
        float* mod = (float*)(ws + WS_MOD);
        bf16_t* UB = (bf16_t*)(ws + WS_UB); bf16_t* ZM = (bf16_t*)(ws + WS_ZM); bf16_t* VT = (bf16_t*)(ws + WS_VT); bf16_t* ZG = (bf16_t*)(ws + WS_ZG);
        bf16_t* HB = (bf16_t*)(ws + WS_H); bf16_t* MG = (bf16_t*)(ws + WS_MG);
        float* outp = ap->out;
        if (ph == 0) {
            LAS float* cact = (LAS float*)(lds + 98304);
            for (int i = tid; i < 8 * D; i += 512) { const float cv = AIN(I_C)[i]; cact[i] = cv * sigmoid_f(cv); }
            __syncthreads();
            LAS float* part = (LAS float*)(lds + 131072);
            for (int it = bx; it < 192; it += G) {
                const int l = it / 96, j = (it % 96) * 64 + lane;
                const float* W = AIN(I_WADA) + (size_t)l * D * 6144 + (size_t)(wave * 128) * 6144 + j;
                float acc[8];
#pragma unroll
                for (int b = 0; b < 8; ++b) acc[b] = 0.f;
                for (int k = 0; k < 128; k += 16) {
                    float wv[16];
#pragma unroll
                    for (int u = 0; u < 16; ++u) wv[u] = W[(size_t)(k + u) * 6144];
#pragma unroll
                    for (int b = 0; b < 8; ++b) {
#pragma unroll
                        for (int q = 0; q < 4; ++q) { const f32x4 c0 = *(const LAS f32x4*)(cact + b * D + wave * 128 + k + 4 * q);
                            acc[b] += (c0.x * wv[4 * q] + c0.y * wv[4 * q + 1]) + (c0.z * wv[4 * q + 2] + c0.w * wv[4 * q + 3]); } }
                }
#pragma unroll
                for (int b = 0; b < 8; ++b) part[(wave * 8 + b) * 64 + lane] = acc[b];
                __syncthreads();
                { float s = AIN(I_BADA)[l * 6144 + j];
#pragma unroll
                  for (int w = 0; w < 8; ++w) s += part[(w * 8 + wave) * 64 + lane];
                  mod[(size_t)(l * 8 + wave) * 6144 + j] = s; }
                __syncthreads();
            }
            LAS float* scr = (LAS float*)(lds + wave * 8704);
            constexpr int PER_L = 7680 + 128;
            for (int it = gw; it < DEPTH * PER_L; it += ngw) {
                const int l = it / PER_L; int r = it % PER_L;
                unsigned char* wl = ws + WS_W + (size_t)l * WS_WL;
                if (r < 2688) { const int k0 = (r / 168) * 64, n0 = (r % 168) * 32;
                    bf16_t* dst = (n0 >= 1280 && n0 < 1792) ? (bf16_t*)(wl + W_V) + (size_t)(n0 - 1280) * D + k0 : (bf16_t*)(wl + W_IN) + (size_t)(n0 >= 1792 ? n0 - 512 : n0) * D + k0;
                    tr_item(AIN(I_WIN) + (size_t)l * D * 5376, 5376, k0, n0, dst, D, scr, lane); continue; } r -= 2688;
                if (r < 256) { const int k0 = (r / 32) * 64, n0 = (r % 32) * 32; tr_item(AIN(I_WBA) + (size_t)l * 512 * D, D, k0, n0, (bf16_t*)(wl + W_BA) + (size_t)n0 * 512 + k0, 512, scr, lane); continue; } r -= 256;
                if (r < 128) { const int k0 = (r / 32) * 64, n0 = (r % 32) * 32; tr_item(AIN(I_WBC) + (size_t)l * 256 * D, D, k0, n0, (bf16_t*)(wl + W_BC) + (size_t)n0 * 256 + k0, 256, scr, lane); continue; } r -= 128;
                if (r < 512) { const int k0 = (r / 32) * 64, n0 = (r % 32) * 32; tr_item(AIN(I_WO) + (size_t)l * D * D, D, k0, n0, (bf16_t*)(wl + W_O) + (size_t)n0 * D + k0, D, scr, lane); continue; } r -= 512;
                if (r < 2048) { const int k0 = (r / 128) * 64, n0 = (r % 128) * 32; tr_item(AIN(I_W1) + (size_t)l * D * DFF, DFF, k0, n0, (bf16_t*)(wl + W_1) + (size_t)n0 * D + k0, D, scr, lane); continue; } r -= 2048;
                if (r < 2048) { const int k0 = (r / 32) * 64, n0 = (r % 32) * 32; tr_item(AIN(I_W2) + (size_t)l * DFF * D, D, k0, n0, (bf16_t*)(wl + W_2) + (size_t)n0 * DFF + k0, DFF, scr, lane); continue; } r -= 2048;
                {
                    const int g = r >> 5, n0 = (r & 31) * 32;
                    const float* ps = AIN(I_PSCALE) + l * 256 + g * 64; const float* wb = AIN(I_WBP) + (size_t)l * 256 * D + (size_t)(g * 64) * D + n0;
#pragma unroll 8
                    for (int i = 0; i < 32; ++i) { const int d = 2 * i + (lane >> 5), n = lane & 31; scr[n * 68 + d] = ps[d] * wb[(size_t)d * D + n]; }
                    LDS_WAIT();
                    f32x4 wpr[16]; const float* wp = AIN(I_WPOOL) + ((size_t)(l * 4 + g) * 64 + lane) * 64;
#pragma unroll
                    for (int q = 0; q < 16; ++q) wpr[q] = *(const f32x4*)(wp + 4 * q);
                    bf16_t* dst = (bf16_t*)(wl + W_BP) + (size_t)n0 * 256 + g * 64 + lane;
                    for (int n = 0; n < 32; ++n) { float acc = 0.f;
#pragma unroll
                        for (int q = 0; q < 16; ++q) { const f32x4 sv = *(const LAS f32x4*)(scr + n * 68 + 4 * q); acc += (wpr[q].x * sv.x + wpr[q].y * sv.y) + (wpr[q].z * sv.z + wpr[q].w * sv.w); }
                        dst[(size_t)n * 256] = (bf16_t)f2bf(acc); }
                    LDS_WAIT();
                }
            }
            __syncthreads();
        } else if (ph == 1) {
            ln_pass<0>(AIN(I_X), nullptr, UB, nullptr, nullptr, mod + 1 * D, mod + 0 * D, gw, ngw, lane);
        } else {
            const int l = (ph - 2) >> 3, sp = (ph - 2) & 7;
            unsigned char* wl = ws + WS_W + (size_t)l * WS_WL;
            const float* modl = mod + (size_t)l * 8 * 6144;
            if (sp == 0) {
                { pg8::Gemm g{UB, (const bf16_t*)(wl + W_IN), M, NWIN, D, D, D}; pg8::StaticOrder S; S.init(M, NWIN, G, bx);
                  pg8::EpiZ E{ZM, ZG, AIN(I_BGATE) + l * 3072};
                  pg8::gemm_phase(lds, tid, g, S, E); }
                { pg8::Gemm g{(const bf16_t*)(wl + W_V), UB, 512, M, D, D, D}; pg8::StaticOrder S; S.init(512, M, G, bx);
                  pg8::EpiBf16<0> E{VT, M, nullptr};
                  pg8::gemm_phase(lds, tid, g, S, E); }
            } else if (sp == 1) {
                LAS float* rbl = (LAS float*)lds;
                for (int i = tid; i < 8 * 257; i += 512) { const int h = i / 257, k = i % 257; rbl[h * 264 + k] = AIN(I_RELB)[(size_t)l * 8 * 257 + i] * LOG2E; }
                __syncthreads();
                for (int unit = vcu; unit < 512; unit += G) { const int b = unit >> 6, n = unit & 63;
                    attn_wave2(ZM, VT, UB, rbl + wave * 264, lds + 16384 + wave * 16384, b, n, wave, lane); }
                for (int it = gw; it < (M / 8) * 4; it += ngw) {
                    const int gi = it & 3, r = (it >> 2) * 8 + (lane >> 3), c0 = gi * 64 + (lane & 7) * 8;
                    if (gi == 0) pool_item<2>(ZM, UB, r, c0); else if (gi == 1) pool_item<4>(ZM, UB, r, c0); else if (gi == 2) pool_item<8>(ZM, UB, r, c0); else pool_item<16>(ZM, UB, r, c0);
                }
                __syncthreads();
                for (int unit = vcu; unit < 1024; unit += G)
                    conv_unit(lds, ZM, UB, AIN(I_CONVW) + l * 31 * 256, AIN(I_CONVB) + l * 256, AIN(I_CLNG) + l * 256, AIN(I_CLNB) + l * 256, unit, tid, wave, lane);
            } else if (sp == 2) {
                for (int br = 0; br < 3; ++br) {
                    const int K = br == 1 ? 512 : 256, aoff = br == 0 ? 0 : (br == 1 ? 256 : 768);
                    const bf16_t* Bt = (const bf16_t*)(wl + (br == 0 ? W_BP : (br == 1 ? W_BA : W_BC)));
                    pg8::Gemm g{UB + aoff, Bt, M, D, K, D, K}; pg8::StaticOrder S; S.init(M, D, G, bx);
                    pg8::EpiGate E{MG, ZG + br * D, br == 0};
                    pg8::gemm_phase(lds, tid, g, S, E);
                }
            } else if (sp == 3 || sp == 6) {
                const bool ff = (sp == 6);
                pg8::Gemm g{ff ? HB : MG, (const bf16_t*)(wl + (ff ? W_2 : W_O)), M, D, ff ? DFF : D, ff ? DFF : D, ff ? DFF : D}; pg8::StaticOrder S; S.init(M, D, G, bx);
                pg8::EpiRes E{(!ff && l == 0) ? AIN(I_X) : outp, outp, modl + (ff ? 5 : 2) * D, ff ? AIN(I_B2) + l * D : nullptr};
                pg8::gemm_phase(lds, tid, g, S, E);
            } else if (sp == 4) {
                ln_pass<1>(outp, outp, UB, AIN(I_LMG) + l * D, AIN(I_LMB) + l * D, modl + 4 * D, modl + 3 * D, gw, ngw, lane);
            } else if (sp == 5) {
                pg8::Gemm g{UB, (const bf16_t*)(wl + W_1), M, DFF, D, D, D}; pg8::StaticOrder S; S.init(M, DFF, G, bx);
                pg8::EpiBf16<1> E{HB, DFF, AIN(I_B1) + l * DFF};
                pg8::gemm_phase(lds, tid, g, S, E);
            } else {
                if (l + 1 < DEPTH) ln_pass<1>(outp, outp, UB, AIN(I_LFG) + l * D, AIN(I_LFB) + l * D, modl + 8 * 6144 + 1 * D, modl + 8 * 6144 + 0 * D, gw, ngw, lane);
                else ln_pass<2>(outp, outp, nullptr, AIN(I_LFG) + l * D, AIN(I_LFB) + l * D, nullptr, nullptr, gw, ngw, lane);
            }
        }
    }
}

extern "C" void kernel_launch(void* const* d_in, const int* in_sizes, int n_in, void* d_out, int out_size, void* d_ws, size_t ws_size, hipStream_t stream) {
    static int grid = 0;
    if (grid == 0) {
        if (n_in != 25 || in_sizes[0] != M * D || out_size != M * D || ws_size < WS_END) {
            fprintf(stderr, "kernel_launch: unexpected shapes: n_in %d in0 %d out %d ws %zu (need %zu); nothing launched\n", n_in, n_in > 0 ? in_sizes[0] : -1, out_size, ws_size, (size_t)WS_END); grid = -1; return; }
        int dev = 0, cus = 0, per_cu = 0;
        if (hipGetDevice(&dev) != hipSuccess || hipDeviceGetAttribute(&cus, hipDeviceAttributeMultiprocessorCount, dev) != hipSuccess) { grid = -1; return; }
        if (hipFuncSetAttribute((const void*)fwd, hipFuncAttributeMaxDynamicSharedMemorySize, LDS_BYTES) != hipSuccess) { fprintf(stderr, "kernel_launch: hipFuncSetAttribute failed\n"); grid = -1; return; }
        if (hipOccupancyMaxActiveBlocksPerMultiprocessor(&per_cu, (const void*)fwd, 512, LDS_BYTES) != hipSuccess || per_cu < 1) { fprintf(stderr, "kernel_launch: occupancy query says %d blocks per CU\n", per_cu); (void)hipGetLastError(); grid = -1; return; }
        grid = cus;
    }
    if (grid < 0) return;
    Args a{};
    for (int i = 0; i < 25; ++i) a.in[i] = (const float*)d_in[i];
    a.out = (float*)d_out; a.ws = (unsigned char*)d_ws;
#if MK_ONE_LAUNCH
    a.ph_lo = 0; a.ph_hi = NPH;
    void* args[] = {&a};
    hipError_t e = hipLaunchCooperativeKernel((const void*)fwd, dim3(grid), dim3(512), args, LDS_BYTES, stream);
    if (e != hipSuccess) fprintf(stderr, "cooperative launch failed: %s (grid %d)\n", hipGetErrorString(e), grid);
#else
    for (int ph = 0; ph < NPH; ++ph) { a.ph_lo = ph; a.ph_hi = ph + 1; hipLaunchKernelGGL(fwd, dim3(grid), dim3(512), LDS_BYTES, stream, a); }
#endif
}
```

```cpp
#include <hip/hip_runtime.h>
#include <hip/hip_cooperative_groups.h>
#include <cstdio>
#include <cstdint>
namespace cg = cooperative_groups;

#ifndef MK_ONE_LAUNCH
#define MK_ONE_LAUNCH 1
#endif

#define LAS __attribute__((address_space(3)))
typedef unsigned short bf16_t;
typedef short bf16x8 __attribute__((ext_vector_type(8)));
typedef float f32x4 __attribute__((ext_vector_type(4)));
typedef float f32x16 __attribute__((ext_vector_type(16)));
typedef unsigned u32x4 __attribute__((ext_vector_type(4)));
typedef unsigned u32x2 __attribute__((ext_vector_type(2)));

constexpr int M = 32768, D = 1024, SEQ = 4096, DFF = 4096, DEPTH = 2;
constexpr int ZM_LD = 1792, ZG_LD = 3072;
constexpr int NWIN = 4864;
constexpr float ALPHA = 1.4142135623730951f;
constexpr float LN_EPS = 1e-5f;
constexpr float LOG2E = 1.4426950408889634f;
constexpr float QSCALE = 0.125f * LOG2E;

constexpr size_t MiB = 1u << 20;
constexpr size_t WS_MOD = 1 * MiB;
constexpr size_t WS_W = 2 * MiB, WS_WL = 31 * MiB;
constexpr size_t W_IN = 0, W_V = 9 * MiB + MiB / 2, W_BP = 10 * MiB + MiB / 2, W_BA = 11 * MiB, W_BC = 12 * MiB, W_O = 12 * MiB + MiB / 2, W_1 = 14 * MiB + MiB / 2, W_2 = 22 * MiB + MiB / 2;
constexpr size_t WS_UB = 64 * MiB;
constexpr size_t WS_ZM = 128 * MiB;
constexpr size_t WS_VT = 240 * MiB;
constexpr size_t WS_ZG = 272 * MiB;
constexpr size_t WS_H = 128 * MiB;
constexpr size_t WS_MG = 128 * MiB;
constexpr size_t WS_END = 464 * MiB;

constexpr int LDS_BYTES = 147456 + 256;
constexpr size_t WS_BAR = 65536;
constexpr int NPH = 2 + 8 * DEPTH;

typedef float f32x2_t __attribute__((ext_vector_type(2))); typedef __bf16 bf16x2_t __attribute__((ext_vector_type(2)));
__device__ __forceinline__ unsigned cvt_pk_bf16(float lo, float hi) { f32x2_t v = {lo, hi}; bf16x2_t b = __builtin_convertvector(v, bf16x2_t); return __builtin_bit_cast(unsigned, b); }
__device__ __forceinline__ float bf_lo(unsigned u) { return __uint_as_float(u << 16); }
__device__ __forceinline__ float bf_hi(unsigned u) { return __uint_as_float(u & 0xffff0000u); }
__device__ __forceinline__ float sigmoid_f(float x) { return __builtin_amdgcn_rcpf(1.f + __builtin_amdgcn_exp2f(-LOG2E * x)); }
__device__ __forceinline__ unsigned f2bf(float f) { unsigned u = __builtin_bit_cast(unsigned, f); return (u + 0x7fffu + ((u >> 16) & 1u)) >> 16; }
__device__ __forceinline__ float wave_sum(float v) {
#pragma unroll
    for (int o = 1; o < 64; o <<= 1) v += __shfl_xor(v, o);
    return v;
}
#define LDS_WAIT() asm volatile("s_waitcnt lgkmcnt(0)" ::: "memory")

namespace pg8 {
constexpr int BM = 256, BK = 64, HALF = 128, HTB = HALF * BK * 2, STAGE_BYTES = 8 * HTB, NXCD = 8, WGM = 8;
__host__ __device__ __forceinline__ int lds_byte(int r, int c) { const int st = (r >> 4) * 2 + (c >> 5), rr = r & 15, cc = c & 31, ob = rr * 64 + cc * 2; return st * 1024 + (ob ^ (((ob >> 9) & 1) << 5)); }
__host__ __device__ __forceinline__ void stage_rc(int b, int& R, int& C) { const int st = b / 1024, sb = b % 1024, swz = sb ^ (((sb >> 9) & 1) << 5); R = (st >> 1) * 16 + swz / 64; C = (st & 1) * 32 + (swz % 64) / 2; }
__host__ __device__ __forceinline__ int perm32(int rho) { const int n = rho >> 4, i = rho & 15; return 8 * (i >> 2) + 4 * n + (i & 3); }

struct Unit { int pm, pn; };
struct Gemm { const bf16_t* A; const bf16_t* Bt; int M, N, K, lda, ldb; };

struct StaticOrder {
    int nM, nN, nwg, G, c;
    __host__ __device__ void init(int M_, int N_, int G_, int c_) { nM = M_ / BM; nN = N_ / BM; nwg = nM * nN; G = G_; c = c_; }
    __host__ __device__ bool next(int i, Unit& u) const {
        const long L = (long)i * G + c; if (L >= nwg) return false;
        int wgid = (int)L; { const int q = nwg / NXCD, r = nwg % NXCD, xcd = wgid % NXCD, off = wgid / NXCD; wgid = (xcd < r ? xcd * (q + 1) : r * (q + 1) + (xcd - r) * q) + off; }
        const int nig = WGM * nN, gid = wgid / nig, fm = gid * WGM, gsz = (nM - fm) < WGM ? (nM - fm) : WGM;
        u.pm = fm + ((wgid % nig) % gsz); u.pn = (wgid % nig) / gsz; return true;
    }
};

typedef f32x4 Acc[2][2][4][2];

template <class Epi>
__device__ __forceinline__ void gemm_phase(LAS unsigned char* lds, const int tid, const Gemm g, const StaticOrder& S, const Epi& E) {
    const int wid = __builtin_amdgcn_readfirstlane(tid >> 6), lane = tid & 63, wr = wid >> 2, wc = wid & 3, fr = lane & 15, fq = lane >> 4;
    const int K = g.K, nt = K / BK;
    unsigned voffA[2], voffB[2];
#pragma unroll
    for (int i = 0; i < 2; ++i) { int R, C; stage_rc(tid * 16 + i * 8192, R, C); const int Rb = Epi::PERM ? ((R & ~31) + perm32(R & 31)) : R;
        voffA[i] = (unsigned)(R * g.lda + C) * 2u; voffB[i] = (unsigned)(Rb * g.ldb + C) * 2u; }
    const size_t kstep = (size_t)(BK * 2);
    const size_t hA = (size_t)HALF * g.lda * 2, hB = (size_t)HALF * g.ldb * 2;
    const size_t tA = 2 * hA, tB = 2 * hB;
    const unsigned ldsw = (unsigned)wid * 1024u;
    const int aoff = lds_byte(wr * 64 + fr, fq * 8), boff = lds_byte(wc * 32 + fr, fq * 8);
#define PG8_SA(b, h) (((b) * 2 + (h)) * HTB)
#define PG8_SB(b, h) ((4 + (b) * 2 + (h)) * HTB)
#define PG8_STAGE(bufoff, gbase, voff) do { _Pragma("unroll") for (int _i = 0; _i < 2; ++_i) \
        __builtin_amdgcn_global_load_lds((const unsigned*)((const char*)(gbase) + (voff)[_i]), (LAS unsigned*)(lds + (bufoff) + ldsw + _i * 8192), 16, 0, 0); } while (0)
#define PG8_LDA(dst, b, h) do { _Pragma("unroll") for (int m = 0; m < 4; ++m) _Pragma("unroll") for (int k = 0; k < 2; ++k) dst[m][k] = *(const LAS bf16x8*)(lds + PG8_SA(b, h) + aoff + m * 2048 + k * 1024); } while (0)
#define PG8_LDB(dst, b, h) do { _Pragma("unroll") for (int n = 0; n < 2; ++n) _Pragma("unroll") for (int k = 0; k < 2; ++k) dst[n][k] = *(const LAS bf16x8*)(lds + PG8_SB(b, h) + boff + n * 2048 + k * 1024); } while (0)
#define PG8_MMA(ai, bj, At, Bt) do { __builtin_amdgcn_s_setprio(1); _Pragma("unroll") for (int m = 0; m < 4; ++m) _Pragma("unroll") for (int n = 0; n < 2; ++n) _Pragma("unroll") for (int k = 0; k < 2; ++k) \
        acc[ai][bj][m][n] = __builtin_amdgcn_mfma_f32_16x16x32_bf16(Bt[n][k], At[m][k], acc[ai][bj][m][n], 0, 0, 0); __builtin_amdgcn_s_setprio(0); } while (0)
#define PG8_WAIT_V(n) asm volatile("s_waitcnt vmcnt(" #n ")" ::: "memory")
#define PG8_WAIT_L(n) asm volatile("s_waitcnt lgkmcnt(" #n ")" ::: "memory")
#define PG8_BAR __builtin_amdgcn_s_barrier()
#define PG8_SCHED __builtin_amdgcn_sched_barrier(0)
    Unit cur, nxt; int ui = 0;
    if (!S.next(0, cur)) return;
    Acc acc;
#pragma unroll
    for (int a = 0; a < 2; ++a)
#pragma unroll
        for (int b = 0; b < 2; ++b)
#pragma unroll
            for (int m = 0; m < 4; ++m)
#pragma unroll
                for (int n = 0; n < 2; ++n) acc[a][b][m][n] = (f32x4){0.f, 0.f, 0.f, 0.f};
    bf16x8 At[4][2], B0[2][2], B1[2][2];
    const char* cA = (const char*)g.A + (size_t)cur.pm * tA; const char* cB = (const char*)g.Bt + (size_t)cur.pn * tB;
    PG8_STAGE(PG8_SB(0, 0), cB, voffB); PG8_STAGE(PG8_SB(0, 1), cB + hB, voffB); PG8_STAGE(PG8_SA(0, 0), cA, voffA); PG8_STAGE(PG8_SA(0, 1), cA + hA, voffA);
    if (wr == 1) PG8_BAR;
    PG8_WAIT_V(2); PG8_BAR;
    PG8_STAGE(PG8_SB(1, 0), cB + kstep, voffB); PG8_STAGE(PG8_SA(1, 0), cA + kstep, voffA); PG8_STAGE(PG8_SB(1, 1), cB + hB + kstep, voffB);
    PG8_WAIT_V(6); PG8_BAR;
    for (;;) {
        const bool has_next = S.next(ui + 1, nxt);
        const char* nA = has_next ? (const char*)g.A + (size_t)nxt.pm * tA : cA; const char* nB = has_next ? (const char*)g.Bt + (size_t)nxt.pn * tB : cB;
        for (int t = 0; t < nt; t += 2) {
            const bool last = (t == nt - 2);
            const char* a1 = cA + (size_t)(t + 1) * kstep;
            const char* a2 = last ? nA : cA + (size_t)(t + 2) * kstep; const char* b2 = last ? nB : cB + (size_t)(t + 2) * kstep;
            const char* a3 = a2 + kstep; const char* b3 = b2 + kstep;
            PG8_LDB(B0, 0, 0); PG8_LDB(B1, 0, 1); PG8_SCHED; PG8_LDA(At, 0, 0); PG8_STAGE(PG8_SA(1, 1), a1 + hA, voffA);
            PG8_WAIT_V(8); PG8_WAIT_L(0); PG8_BAR; PG8_MMA(0, 0, At, B0); PG8_MMA(0, 1, At, B1); PG8_BAR; PG8_SCHED;
            PG8_LDA(At, 0, 1); PG8_STAGE(PG8_SB(0, 0), b2, voffB); PG8_STAGE(PG8_SB(0, 1), b2 + hB, voffB); PG8_STAGE(PG8_SA(0, 0), a2, voffA);
            PG8_WAIT_V(8); PG8_WAIT_L(0); PG8_BAR; PG8_MMA(1, 0, At, B0); PG8_MMA(1, 1, At, B1); PG8_BAR; PG8_SCHED;
            PG8_LDB(B0, 1, 0); PG8_LDB(B1, 1, 1); PG8_SCHED; PG8_LDA(At, 1, 0); PG8_STAGE(PG8_SA(0, 1), a2 + hA, voffA);
            PG8_WAIT_V(8); PG8_WAIT_L(0); PG8_BAR; PG8_MMA(0, 0, At, B0); PG8_MMA(0, 1, At, B1); PG8_BAR; PG8_SCHED;
            PG8_LDA(At, 1, 1); PG8_STAGE(PG8_SB(1, 0), b3, voffB); PG8_STAGE(PG8_SB(1, 1), b3 + hB, voffB); PG8_STAGE(PG8_SA(1, 0), a3, voffA);
            PG8_WAIT_V(8); PG8_WAIT_L(0); PG8_BAR; PG8_MMA(1, 0, At, B0); PG8_MMA(1, 1, At, B1); PG8_BAR; PG8_SCHED;
        }
        if (wr == 0) PG8_BAR;
        E(acc, cur, wr, wc, fr, fq);
        if (!has_next) break;
#pragma unroll
        for (int a = 0; a < 2; ++a)
#pragma unroll
            for (int b = 0; b < 2; ++b)
#pragma unroll
                for (int m = 0; m < 4; ++m)
#pragma unroll
                    for (int n = 0; n < 2; ++n) acc[a][b][m][n] = (f32x4){0.f, 0.f, 0.f, 0.f};
        cur = nxt; cA = nA; cB = nB; ++ui;
        if (wr == 1) PG8_BAR;
    }
    PG8_WAIT_V(0);
    PG8_BAR;
#undef PG8_SA
#undef PG8_SB
#undef PG8_STAGE
#undef PG8_LDA
#undef PG8_LDB
#undef PG8_MMA
#undef PG8_WAIT_V
#undef PG8_WAIT_L
#undef PG8_BAR
#undef PG8_SCHED
}

struct EpiZ {
    static constexpr bool PERM = true;
    bf16_t* zm; bf16_t* zg; const float* bgate;
    __device__ __forceinline__ void operator()(const Acc& acc, const Unit& u, int wr, int wc, int fr, int fq) const {
        const int row0 = u.pm * BM + wr * 64 + fr;
        if (u.pn < 7) {
            const float sc = (u.pn == 1 || u.pn == 2) ? QSCALE : 1.f;
            const int col0 = u.pn * BM + wc * 32 + 8 * fq;
#pragma unroll
            for (int ai = 0; ai < 2; ++ai)
#pragma unroll
                for (int m = 0; m < 4; ++m) { bf16_t* rowp = zm + (size_t)(row0 + ai * HALF + m * 16) * ZM_LD + col0;
#pragma unroll
                    for (int bj = 0; bj < 2; ++bj) { const f32x4 v0 = acc[ai][bj][m][0] * sc, v1 = acc[ai][bj][m][1] * sc;
                        u32x4 w; w.x = cvt_pk_bf16(v0[0], v0[1]); w.y = cvt_pk_bf16(v0[2], v0[3]); w.z = cvt_pk_bf16(v1[0], v1[1]); w.w = cvt_pk_bf16(v1[2], v1[3]);
                        *(u32x4*)(rowp + bj * HALF) = w; } }
        } else {
            const int col0 = (u.pn - 7) * BM + wc * 32 + 8 * fq;
            f32x4 bv[2][2];
#pragma unroll
            for (int bj = 0; bj < 2; ++bj)
#pragma unroll
                for (int n = 0; n < 2; ++n) bv[bj][n] = *(const f32x4*)(bgate + col0 + bj * HALF + 4 * n);
#pragma unroll
            for (int ai = 0; ai < 2; ++ai)
#pragma unroll
                for (int m = 0; m < 4; ++m) { bf16_t* rowp = zg + (size_t)(row0 + ai * HALF + m * 16) * ZG_LD + col0;
#pragma unroll
                    for (int bj = 0; bj < 2; ++bj) { f32x4 v0 = acc[ai][bj][m][0] + bv[bj][0], v1 = acc[ai][bj][m][1] + bv[bj][1];
#pragma unroll
                        for (int e = 0; e < 4; ++e) { v0[e] = sigmoid_f(v0[e]); v1[e] = sigmoid_f(v1[e]); }
                        u32x4 w; w.x = cvt_pk_bf16(v0[0], v0[1]); w.y = cvt_pk_bf16(v0[2], v0[3]); w.z = cvt_pk_bf16(v1[0], v1[1]); w.w = cvt_pk_bf16(v1[2], v1[3]);
                        *(u32x4*)(rowp + bj * HALF) = w; } }
        }
    }
};
template <int ACT> struct EpiBf16 {
    static constexpr bool PERM = true;
    bf16_t* O; int ldc; const float* bias;
    __device__ __forceinline__ void operator()(const Acc& acc, const Unit& u, int wr, int wc, int fr, int fq) const {
        const int row0 = u.pm * BM + wr * 64 + fr, col0 = u.pn * BM + wc * 32 + 8 * fq;
        f32x4 bv[2][2];
#pragma unroll
        for (int bj = 0; bj < 2; ++bj)
#pragma unroll
            for (int n = 0; n < 2; ++n) bv[bj][n] = ACT ? *(const f32x4*)(bias + col0 + bj * HALF + 4 * n) : (f32x4){0.f, 0.f, 0.f, 0.f};
#pragma unroll
        for (int ai = 0; ai < 2; ++ai)
#pragma unroll
            for (int m = 0; m < 4; ++m) { bf16_t* rowp = O + (size_t)(row0 + ai * HALF + m * 16) * ldc + col0;
#pragma unroll
                for (int bj = 0; bj < 2; ++bj) { f32x4 v0 = acc[ai][bj][m][0] + bv[bj][0], v1 = acc[ai][bj][m][1] + bv[bj][1];
                    if (ACT) {
#pragma unroll
                        for (int e = 0; e < 4; ++e) { const float a = fmaxf(v0[e], 0.f), b = fmaxf(v1[e], 0.f); v0[e] = a * a; v1[e] = b * b; } }
                    u32x4 w; w.x = cvt_pk_bf16(v0[0], v0[1]); w.y = cvt_pk_bf16(v0[2], v0[3]); w.z = cvt_pk_bf16(v1[0], v1[1]); w.w = cvt_pk_bf16(v1[2], v1[3]);
                    *(u32x4*)(rowp + bj * HALF) = w; } }
    }
};
struct EpiGate {
    static constexpr bool PERM = true;
    bf16_t* mg; const bf16_t* zg; int first;
    __device__ __forceinline__ void operator()(const Acc& acc, const Unit& u, int wr, int wc, int fr, int fq) const {
        const int row0 = u.pm * BM + wr * 64 + fr, col0 = u.pn * BM + wc * 32 + 8 * fq;
#pragma unroll
        for (int ai = 0; ai < 2; ++ai)
#pragma unroll
            for (int m = 0; m < 4; ++m) { const size_t r = (size_t)(row0 + ai * HALF + m * 16);
#pragma unroll
                for (int bj = 0; bj < 2; ++bj) {
                    const u32x4 gv = *(const u32x4*)(zg + r * ZG_LD + col0 + bj * HALF);
                    bf16_t* mp = mg + r * D + col0 + bj * HALF;
                    u32x4 ov = (u32x4){0u, 0u, 0u, 0u}; if (!first) ov = *(const u32x4*)mp;
                    const f32x4 a0 = acc[ai][bj][m][0], a1 = acc[ai][bj][m][1];
                    u32x4 w;
                    w.x = cvt_pk_bf16(bf_lo(ov.x) + bf_lo(gv.x) * a0[0], bf_hi(ov.x) + bf_hi(gv.x) * a0[1]);
                    w.y = cvt_pk_bf16(bf_lo(ov.y) + bf_lo(gv.y) * a0[2], bf_hi(ov.y) + bf_hi(gv.y) * a0[3]);
                    w.z = cvt_pk_bf16(bf_lo(ov.z) + bf_lo(gv.z) * a1[0], bf_hi(ov.z) + bf_hi(gv.z) * a1[1]);
                    w.w = cvt_pk_bf16(bf_lo(ov.w) + bf_lo(gv.w) * a1[2], bf_hi(ov.w) + bf_hi(gv.w) * a1[3]);
                    *(u32x4*)mp = w; } }
    }
};
struct EpiRes {
    static constexpr bool PERM = false;
    const float* xin; float* out; const float* gvec; const float* bias;
    __device__ __forceinline__ void operator()(const Acc& acc, const Unit& u, int wr, int wc, int fr, int fq) const {
        const int row0 = u.pm * BM + wr * 64 + fr, col0 = u.pn * BM + wc * 32 + 4 * fq;
        const float* gp = gvec + (size_t)(u.pm >> 4) * 6144;
#pragma unroll
        for (int bj = 0; bj < 2; ++bj)
#pragma unroll
            for (int n = 0; n < 2; ++n) { const int col = col0 + bj * HALF + n * 16;
                const f32x4 gv = *(const f32x4*)(gp + col); const f32x4 bv = bias ? *(const f32x4*)(bias + col) : (f32x4){0.f, 0.f, 0.f, 0.f};
#pragma unroll
                for (int ai = 0; ai < 2; ++ai)
#pragma unroll
                    for (int m = 0; m < 4; ++m) { const size_t off = (size_t)(row0 + ai * HALF + m * 16) * D + col;
                        const f32x4 xv = *(const f32x4*)(xin + off);
                        *(f32x4*)(out + off) = xv * ALPHA + gv * (acc[ai][bj][m][n] + bv); } }
    }
};
}


#define RLX_AGENT __ATOMIC_RELAXED, __HIP_MEMORY_SCOPE_AGENT
#define XB_TMO      128
#define XB_XCNT(j)  (256  + 64 * (j))
#define XB_XSUB(j)  (1280 + 64 * (j))
#define XB_XGEN(j)  (2304 + 64 * (j))
#define XB_TOP      3328
#define XB_TOPGEN   3392
#define XCD_BAR_WORDS 3456
#define XB_SPIN_CAP (1u << 18)

__device__ __forceinline__ unsigned xb_ld(unsigned* p)              { return __hip_atomic_load(p, __ATOMIC_RELAXED, __HIP_MEMORY_SCOPE_AGENT); }
__device__ __forceinline__ unsigned xb_add(unsigned* p, unsigned v) { return __hip_atomic_fetch_add(p, v, __ATOMIC_RELAXED, __HIP_MEMORY_SCOPE_AGENT); }
__device__ __forceinline__ unsigned xb_xcc_id() { return (unsigned)__builtin_amdgcn_s_getreg((3 << 11) | 20) & 0xFu; }
#define XB_SPIN(cond, bar) do { unsigned _sp = 0; while (cond) { __builtin_amdgcn_s_sleep(1); \
    if ((++_sp & 255u) == 0u) { if (xb_ld(&(bar)[XB_TMO])) break; if (_sp > XB_SPIN_CAP) { atomicAdd(&(bar)[XB_TMO], 1u); break; } } } } while (0)

struct XcdBarrier {
    unsigned* bar; unsigned x;
    volatile LAS unsigned* st;
};

__device__ __forceinline__ XcdBarrier xcd_barrier_post(unsigned* bar, volatile LAS unsigned* st) {
    XcdBarrier b; b.bar = bar; b.x = xb_xcc_id(); b.st = st;
    if (threadIdx.x == 0) (void)xb_add(&bar[XB_XCNT(b.x)], 1u);
    return b;
}
__device__ __forceinline__ void xcd_barrier_complete(unsigned* bar, unsigned x, unsigned& nloc, unsigned& nx) {
    const unsigned G = gridDim.x * gridDim.y * gridDim.z;
    unsigned sum, cnt, mine, sp = 0u;
    for (;;) {
        sum = 0u; cnt = 0u; mine = 0u;
#pragma unroll
        for (unsigned j = 0; j < 16; ++j) { const unsigned c = xb_ld(&bar[XB_XCNT(j)]); sum += c; cnt += (c > 0u) ? 1u : 0u; mine = (j == x) ? c : mine; }
        if (sum == G) break;
        __builtin_amdgcn_s_sleep(1);
        if ((++sp & 255u) == 0u) { if (xb_ld(&bar[XB_TMO])) break; if (sp > XB_SPIN_CAP) { atomicAdd(&bar[XB_TMO], 1u); break; } }
    }
    nloc = mine > 0u ? mine : 1u; nx = cnt > 0u ? cnt : 1u;
}

__device__ __forceinline__ void xcd_barrier(const XcdBarrier& b) {
    asm volatile("s_waitcnt vmcnt(0)" ::: "memory");
    __syncthreads();
    if (threadIdx.x == 0) {
        unsigned* bar = b.bar;
        __builtin_amdgcn_s_waitcnt(0);
        unsigned nloc = b.st[0], nx = b.st[1];
        if (nloc == 0u) { xcd_barrier_complete(bar, b.x, nloc, nx); b.st[0] = nloc; b.st[1] = nx; }
        const unsigned old = xb_add(&bar[XB_XSUB(b.x)], 1u);
        const unsigned gen = old / nloc;
        if (old + 1u == (gen + 1u) * nloc) {
            __builtin_amdgcn_fence(__ATOMIC_RELEASE, "agent");
            asm volatile("s_waitcnt vmcnt(0)" ::: "memory");
            const unsigned og = xb_add(&bar[XB_TOP], 1u);
            const unsigned tg = og / nx;
            if (og + 1u == (tg + 1u) * nx) xb_add(&bar[XB_TOPGEN], 1u);
            else XB_SPIN(xb_ld(&bar[XB_TOPGEN]) == tg, bar);
            __builtin_amdgcn_fence(__ATOMIC_ACQUIRE, "agent");
            xb_add(&bar[XB_XGEN(b.x)], 1u);
            asm volatile("s_waitcnt vmcnt(0)" ::: "memory");
        } else {
            XB_SPIN(xb_ld(&bar[XB_XGEN(b.x)]) == gen, bar);
            __builtin_amdgcn_fence(__ATOMIC_ACQUIRE, "agent");
            asm volatile("s_waitcnt vmcnt(0)" ::: "memory");
        }
    }
    __syncthreads();
}

struct Args { const float* in[25]; float* out; unsigned char* ws; int ph_lo, ph_hi; };
enum { I_X = 0, I_C, I_WADA, I_BADA, I_WIN, I_BGATE, I_WPOOL, I_PSCALE, I_RELB, I_CONVW, I_CONVB, I_CLNG, I_CLNB, I_WBP, I_WBA, I_WBC, I_WO, I_LMG, I_LMB, I_W1, I_B1, I_W2, I_B2, I_LFG, I_LFB };

__device__ __forceinline__ void tr_item(const float* W, int N, int k0, int n0, bf16_t* dst, int dK, LAS float* scr, int lane) {
    float tv[32];
#pragma unroll
    for (int i = 0; i < 32; ++i) tv[i] = W[(size_t)(k0 + 2 * i + (lane >> 5)) * N + n0 + (lane & 31)];
#pragma unroll
    for (int i = 0; i < 32; ++i) scr[(2 * i + (lane >> 5)) * 33 + (lane & 31)] = tv[i];
    LDS_WAIT();
    const int c = lane & 7;
#pragma unroll
    for (int j = 0; j < 4; ++j) { const int n = (lane >> 3) + 8 * j; const LAS float* s = scr + (8 * c) * 33 + n;
        u32x4 o; o.x = f2bf(s[0 * 33]) | (f2bf(s[1 * 33]) << 16); o.y = f2bf(s[2 * 33]) | (f2bf(s[3 * 33]) << 16); o.z = f2bf(s[4 * 33]) | (f2bf(s[5 * 33]) << 16); o.w = f2bf(s[6 * 33]) | (f2bf(s[7 * 33]) << 16);
        *(u32x4*)(dst + (size_t)n * dK + 8 * c) = o; }
    LDS_WAIT();
}

template <int MODE>
__device__ __forceinline__ void ln_pass(const float* src, float* dst, bf16_t* u, const float* g, const float* bb, const float* modsc, const float* modsh, int gw, int ngw, int lane) {
    for (int row0 = gw * 16; row0 < M; row0 += ngw * 16) {
        const int batch = row0 >> 12;
        f32x4 gv[4], bv[4], scv[4], shv[4];
#pragma unroll
        for (int j = 0; j < 4; ++j) {
            if (MODE >= 1) { gv[j] = *(const f32x4*)(g + 4 * lane + 256 * j); bv[j] = *(const f32x4*)(bb + 4 * lane + 256 * j); }
            if (MODE != 2) { scv[j] = *(const f32x4*)(modsc + (size_t)batch * 6144 + 4 * lane + 256 * j) + 1.f; shv[j] = *(const f32x4*)(modsh + (size_t)batch * 6144 + 4 * lane + 256 * j); }
        }
        f32x4 nv[4], nw[4];
#pragma unroll
        for (int j = 0; j < 4; ++j) { nv[j] = *(const f32x4*)(src + (size_t)row0 * D + 4 * lane + 256 * j); nw[j] = *(const f32x4*)(src + (size_t)(row0 + 1) * D + 4 * lane + 256 * j); }
        for (int r = 0; r < 16; ++r) {
            const size_t off = (size_t)(row0 + r) * D + 4 * lane;
            f32x4 v[4];
#pragma unroll
            for (int j = 0; j < 4; ++j) { v[j] = nv[j]; nv[j] = nw[j]; }
            if (r < 14) {
#pragma unroll
                for (int j = 0; j < 4; ++j) nw[j] = *(const f32x4*)(src + off + 2 * D + 256 * j);
            }
            float s = 0.f;
#pragma unroll
            for (int j = 0; j < 4; ++j) s += (v[j].x + v[j].y) + (v[j].z + v[j].w);
            float mean = wave_sum(s) * (1.f / D), s2 = 0.f;
#pragma unroll
            for (int j = 0; j < 4; ++j) { v[j] = v[j] - mean; s2 += (v[j].x * v[j].x + v[j].y * v[j].y) + (v[j].z * v[j].z + v[j].w * v[j].w); }
            float rstd = 1.f / sqrtf(wave_sum(s2) * (1.f / D) + LN_EPS);
            if (MODE >= 1) {
                s = 0.f;
#pragma unroll
                for (int j = 0; j < 4; ++j) { v[j] = v[j] * rstd * gv[j] + bv[j]; *(f32x4*)(dst + off + 256 * j) = v[j]; s += (v[j].x + v[j].y) + (v[j].z + v[j].w); }
                if (MODE == 1) {
                    mean = wave_sum(s) * (1.f / D); s2 = 0.f;
#pragma unroll
                    for (int j = 0; j < 4; ++j) { v[j] = v[j] - mean; s2 += (v[j].x * v[j].x + v[j].y * v[j].y) + (v[j].z * v[j].z + v[j].w * v[j].w); }
                    rstd = 1.f / sqrtf(wave_sum(s2) * (1.f / D) + LN_EPS);
                }
            }
            if (MODE != 2) {
#pragma unroll
                for (int j = 0; j < 4; ++j) { const f32x4 o = v[j] * rstd * scv[j] + shv[j]; u32x2 w; w.x = cvt_pk_bf16(o.x, o.y); w.y = cvt_pk_bf16(o.z, o.w); *(u32x2*)(u + off + 256 * j) = w; }
            }
        }
    }
}

__device__ __forceinline__ void attn_wave(const bf16_t* zm, const bf16_t* vt, bf16_t* bcat, const LAS float* rb  , int b, int n, int h, int qh, int lane) {
    const int r32 = lane & 31, hi = lane >> 5;
    const size_t tok0 = (size_t)b * SEQ + (size_t)n * 64;
    const bf16_t* qp = zm + (tok0 + qh * 32 + r32) * ZM_LD + 256 + h * 64 + hi * 8;
    bf16x8 qf[4];
#pragma unroll
    for (int d0 = 0; d0 < 4; ++d0) qf[d0] = *(const bf16x8*)(qp + d0 * 16);
    const int pi = (r32 & ~12) | ((r32 & 4) << 1) | ((r32 & 8) >> 1);
    float m_run = -1e30f, l_run = 0.f;
    f32x16 o[2];
#pragma unroll
    for (int r = 0; r < 16; ++r) { o[0][r] = 0.f; o[1][r] = 0.f; }
    const int qi = qh * 32 + r32;
    const int jlo = n < 8 ? 8 - n : 0;
    bf16x8 kf[2][4];
    {   const size_t kt0 = tok0 - (size_t)(8 - jlo) * 64;
#pragma unroll
        for (int kb = 0; kb < 2; ++kb) { const bf16_t* kp = zm + (kt0 + kb * 32 + pi) * ZM_LD + 768 + h * 64 + hi * 8;
#pragma unroll
            for (int d0 = 0; d0 < 4; ++d0) kf[kb][d0] = *(const bf16x8*)(kp + d0 * 16); } }
    for (int j = jlo; j <= 8; ++j) {
        const int delta = 8 - j;
        const size_t kt0 = tok0 - (size_t)delta * 64;
        bf16x8 vf[2][4], kn[2][4];
#pragma unroll
        for (int db = 0; db < 2; ++db) { const bf16_t* vp = vt + (size_t)(h * 64 + db * 32 + r32) * M + kt0 + hi * 8;
#pragma unroll
            for (int c = 0; c < 4; ++c) vf[db][c] = *(const bf16x8*)(vp + c * 16); }
        {   const size_t kt1 = kt0 + (j < 8 ? 64 : 0);
#pragma unroll
            for (int kb = 0; kb < 2; ++kb) { const bf16_t* kp = zm + (kt1 + kb * 32 + pi) * ZM_LD + 768 + h * 64 + hi * 8;
#pragma unroll
                for (int d0 = 0; d0 < 4; ++d0) kn[kb][d0] = *(const bf16x8*)(kp + d0 * 16); } }
        f32x16 s[2];
#pragma unroll
        for (int kb = 0; kb < 2; ++kb) {
#pragma unroll
            for (int r = 0; r < 16; ++r) s[kb][r] = 0.f;
#pragma unroll
            for (int d0 = 0; d0 < 4; ++d0) s[kb] = __builtin_amdgcn_mfma_f32_32x32x16_bf16(kf[kb][d0], qf[d0], s[kb], 0, 0, 0);
        }
        if (delta >= 3) {
            const float cb = rb[256];
#pragma unroll
            for (int kb = 0; kb < 2; ++kb)
#pragma unroll
                for (int r = 0; r < 16; ++r) s[kb][r] += cb;
        } else {
            const int base = delta * 64 + qi - 8 * hi;
#pragma unroll
            for (int kb = 0; kb < 2; ++kb)
#pragma unroll
                for (int r = 0; r < 16; ++r) { int dd = base - (kb * 32 + 16 * (r >> 3) + (r & 7)); dd = dd > 128 ? 128 : dd; s[kb][r] += rb[dd + 128]; }
        }
        float mx = s[0][0];
#pragma unroll
        for (int kb = 0; kb < 2; ++kb)
#pragma unroll
            for (int r = 0; r < 16; ++r) mx = fmaxf(mx, s[kb][r]);
        mx = fmaxf(mx, __shfl_xor(mx, 32));
        const float m_new = fmaxf(m_run, mx);
        const float f = __builtin_amdgcn_exp2f(m_run - m_new);
        m_run = m_new;
        float ps = 0.f;
#pragma unroll
        for (int kb = 0; kb < 2; ++kb)
#pragma unroll
            for (int r = 0; r < 16; ++r) { s[kb][r] = __builtin_amdgcn_exp2f(s[kb][r] - m_new); ps += s[kb][r]; }
        l_run = l_run * f + ps;
#pragma unroll
        for (int r = 0; r < 16; ++r) { o[0][r] *= f; o[1][r] *= f; }
        bf16x8 pf[4];
#pragma unroll
        for (int c = 0; c < 4; ++c) { const int kb = c >> 1, s8 = (c & 1) * 8; u32x4 w;
            w.x = cvt_pk_bf16(s[kb][s8 + 0], s[kb][s8 + 1]); w.y = cvt_pk_bf16(s[kb][s8 + 2], s[kb][s8 + 3]); w.z = cvt_pk_bf16(s[kb][s8 + 4], s[kb][s8 + 5]); w.w = cvt_pk_bf16(s[kb][s8 + 6], s[kb][s8 + 7]);
            pf[c] = __builtin_bit_cast(bf16x8, w); }
#pragma unroll
        for (int db = 0; db < 2; ++db)
#pragma unroll
            for (int c = 0; c < 4; ++c) o[db] = __builtin_amdgcn_mfma_f32_32x32x16_bf16(vf[db][c], pf[c], o[db], 0, 0, 0);
#pragma unroll
        for (int kb = 0; kb < 2; ++kb)
#pragma unroll
            for (int d0 = 0; d0 < 4; ++d0) kf[kb][d0] = kn[kb][d0];
    }
    const float l = l_run + __shfl_xor(l_run, 32);
    const float inv = 1.f / l;
    bf16_t* op = bcat + (tok0 + qh * 32 + r32) * D + 256 + h * 64 + 4 * hi;
#pragma unroll
    for (int db = 0; db < 2; ++db)
#pragma unroll
        for (int g4 = 0; g4 < 4; ++g4) { u32x2 w; w.x = cvt_pk_bf16(o[db][4 * g4 + 0] * inv, o[db][4 * g4 + 1] * inv); w.y = cvt_pk_bf16(o[db][4 * g4 + 2] * inv, o[db][4 * g4 + 3] * inv);
            *(u32x2*)(op + db * 32 + 8 * g4) = w; }
}


__device__ __forceinline__ void attn_wave2(const bf16_t* zm, const bf16_t* vt, bf16_t* bcat, const LAS float* rb, LAS unsigned char* wl, int b, int n, int h, int lane) {
    const int r32 = lane & 31, hi = lane >> 5;
    const size_t tok0 = (size_t)b * SEQ + (size_t)n * 64;
    bf16x8 qf[2][4];
#pragma unroll
    for (int qh = 0; qh < 2; ++qh)
#pragma unroll
        for (int d0 = 0; d0 < 4; ++d0) qf[qh][d0] = *(const bf16x8*)(zm + (tok0 + qh * 32 + r32) * ZM_LD + 256 + h * 64 + hi * 8 + d0 * 16);
    const int drow = lane >> 3, dch = (lane & 7) ^ drow;
    const bf16_t* ksrc = zm + (size_t)((drow & 3) + ((drow >> 2) << 3)) * ZM_LD + 768 + h * 64 + dch * 8;
    const bf16_t* vsrc = vt + (size_t)(h * 64 + drow) * M + dch * 8;
    const int kfo = r32 * 128, sw = r32 & 7;
    float m_run[2] = {-1e30f, -1e30f}, l_run[2] = {0.f, 0.f};
    f32x16 o[2][2];
#pragma unroll
    for (int r = 0; r < 16; ++r) { o[0][0][r] = 0.f; o[0][1][r] = 0.f; o[1][0][r] = 0.f; o[1][1][r] = 0.f; }
    const int jlo = n < 8 ? 8 - n : 0;
#define ATT_DMA_K(kt) do { _Pragma("unroll") for (int _i = 0; _i < 8; ++_i) __builtin_amdgcn_global_load_lds((const unsigned*)(ksrc + ((kt) + (size_t)(((_i & 1) << 2) + (((_i >> 1) & 1) << 4) + ((_i >> 2) << 5))) * ZM_LD), (LAS unsigned*)(wl + _i * 1024), 16, 0, 0); } while (0)
#define ATT_DMA_V(kt) do { _Pragma("unroll") for (int _i = 0; _i < 8; ++_i) __builtin_amdgcn_global_load_lds((const unsigned*)(vsrc + (size_t)(8 * _i) * M + (kt)), (LAS unsigned*)(wl + 8192 + _i * 1024), 16, 0, 0); } while (0)
    { const size_t kt0 = tok0 - (size_t)(8 - jlo) * 64; ATT_DMA_K(kt0); ATT_DMA_V(kt0); }
    for (int j = jlo; j <= 8; ++j) {
        const int delta = 8 - j; const bool last = (j == 8);
        const size_t kt0 = tok0 - (size_t)delta * 64;
        asm volatile("s_waitcnt vmcnt(8)" ::: "memory");
        bf16x8 pf[2][4];
#pragma unroll
        for (int qh = 0; qh < 2; ++qh) {
            f32x16 s[2];
#pragma unroll
            for (int kb = 0; kb < 2; ++kb) {
#pragma unroll
                for (int r = 0; r < 16; ++r) s[kb][r] = 0.f;
#pragma unroll
                for (int d0 = 0; d0 < 4; ++d0) { const bf16x8 kfr = *(const LAS bf16x8*)(wl + kb * 4096 + kfo + (((2 * d0 + hi) ^ sw) * 16));
                    s[kb] = __builtin_amdgcn_mfma_f32_32x32x16_bf16(kfr, qf[qh][d0], s[kb], 0, 0, 0); }
            }
            if (qh == 1 && !last) { asm volatile("s_waitcnt lgkmcnt(0)" ::: "memory"); ATT_DMA_K(kt0 + 64); }
            const int qi = qh * 32 + r32;
            if (delta >= 3) {
                const float cb = rb[256];
#pragma unroll
                for (int kb = 0; kb < 2; ++kb)
#pragma unroll
                    for (int r = 0; r < 16; ++r) s[kb][r] += cb;
            } else {
                const int base = delta * 64 + qi - 8 * hi;
#pragma unroll
                for (int kb = 0; kb < 2; ++kb)
#pragma unroll
                    for (int r = 0; r < 16; ++r) { int dd = base - (kb * 32 + 16 * (r >> 3) + (r & 7)); dd = dd > 128 ? 128 : dd; s[kb][r] += rb[dd + 128]; }
            }
            float mx = s[0][0];
#pragma unroll
            for (int kb = 0; kb < 2; ++kb)
#pragma unroll
                for (int r = 0; r < 16; ++r) mx = fmaxf(mx, s[kb][r]);
            mx = fmaxf(mx, __shfl_xor(mx, 32));
            const float m_new = fmaxf(m_run[qh], mx);
            const float f = __builtin_amdgcn_exp2f(m_run[qh] - m_new);
            m_run[qh] = m_new;
            float ps = 0.f;
#pragma unroll
            for (int kb = 0; kb < 2; ++kb)
#pragma unroll
                for (int r = 0; r < 16; ++r) { s[kb][r] = __builtin_amdgcn_exp2f(s[kb][r] - m_new); ps += s[kb][r]; }
            l_run[qh] = l_run[qh] * f + ps;
#pragma unroll
            for (int r = 0; r < 16; ++r) { o[qh][0][r] *= f; o[qh][1][r] *= f; }
#pragma unroll
            for (int c = 0; c < 4; ++c) { const int kb = c >> 1, s8 = (c & 1) * 8; u32x4 w;
                w.x = cvt_pk_bf16(s[kb][s8 + 0], s[kb][s8 + 1]); w.y = cvt_pk_bf16(s[kb][s8 + 2], s[kb][s8 + 3]); w.z = cvt_pk_bf16(s[kb][s8 + 4], s[kb][s8 + 5]); w.w = cvt_pk_bf16(s[kb][s8 + 6], s[kb][s8 + 7]);
                pf[qh][c] = __builtin_bit_cast(bf16x8, w); }
        }
        if (!last) asm volatile("s_waitcnt vmcnt(8)" ::: "memory"); else asm volatile("s_waitcnt vmcnt(0)" ::: "memory");
#pragma unroll
        for (int db = 0; db < 2; ++db)
#pragma unroll
            for (int c = 0; c < 4; ++c) { const bf16x8 vfr = *(const LAS bf16x8*)(wl + 8192 + db * 4096 + kfo + (((2 * c + hi) ^ sw) * 16));
                o[0][db] = __builtin_amdgcn_mfma_f32_32x32x16_bf16(vfr, pf[0][c], o[0][db], 0, 0, 0);
                o[1][db] = __builtin_amdgcn_mfma_f32_32x32x16_bf16(vfr, pf[1][c], o[1][db], 0, 0, 0); }
        if (!last) { asm volatile("s_waitcnt lgkmcnt(0)" ::: "memory"); ATT_DMA_V(kt0 + 64); }
    }
#undef ATT_DMA_K
#undef ATT_DMA_V
#pragma unroll
    for (int qh = 0; qh < 2; ++qh) {
        const float l = l_run[qh] + __shfl_xor(l_run[qh], 32);
        const float inv = 1.f / l;
        bf16_t* op = bcat + (tok0 + qh * 32 + r32) * D + 256 + h * 64 + 4 * hi;
#pragma unroll
        for (int db = 0; db < 2; ++db)
#pragma unroll
            for (int g4 = 0; g4 < 4; ++g4) { u32x2 w; w.x = cvt_pk_bf16(o[qh][db][4 * g4 + 0] * inv, o[qh][db][4 * g4 + 1] * inv); w.y = cvt_pk_bf16(o[qh][db][4 * g4 + 2] * inv, o[qh][db][4 * g4 + 3] * inv);
                *(u32x2*)(op + db * 32 + 8 * g4) = w; }
    }
}

template <int W>
__device__ __forceinline__ void pool_item(const bf16_t* zm, bf16_t* ub, int r, int c0) {
    const int t = r & (SEQ - 1), cnt = (t + 1) < W ? (t + 1) : W;
    const bf16_t* p = zm + (size_t)r * ZM_LD + c0;
    u32x4 v[W];
#pragma unroll
    for (int i = 0; i < W; ++i) { v[i] = (u32x4){0u, 0u, 0u, 0u}; if (i < cnt) v[i] = *(const u32x4*)(p - (size_t)i * ZM_LD); }
    float s[8];
#pragma unroll
    for (int e = 0; e < 8; ++e) s[e] = 0.f;
#pragma unroll
    for (int i = 0; i < W; ++i) { s[0] += bf_lo(v[i].x); s[1] += bf_hi(v[i].x); s[2] += bf_lo(v[i].y); s[3] += bf_hi(v[i].y); s[4] += bf_lo(v[i].z); s[5] += bf_hi(v[i].z); s[6] += bf_lo(v[i].w); s[7] += bf_hi(v[i].w); }
    const float inv = 1.f / (float)cnt;
    u32x4 o; o.x = cvt_pk_bf16(s[0] * inv - bf_lo(v[0].x), s[1] * inv - bf_hi(v[0].x)); o.y = cvt_pk_bf16(s[2] * inv - bf_lo(v[0].y), s[3] * inv - bf_hi(v[0].y));
    o.z = cvt_pk_bf16(s[4] * inv - bf_lo(v[0].z), s[5] * inv - bf_hi(v[0].z)); o.w = cvt_pk_bf16(s[6] * inv - bf_lo(v[0].w), s[7] * inv - bf_hi(v[0].w));
    *(u32x4*)(ub + (size_t)r * D + c0) = o;
}

__device__ __forceinline__ void conv_unit(LAS unsigned char* lds, const bf16_t* zm, bf16_t* bcat, const float* cw, const float* cb, const float* lg, const float* lb, int unit, int tid, int wave, int lane) {
    LAS float* hbuf = (LAS float*)(lds + 16384);
    LAS float* obuf = (LAS float*)(lds + 16384 + 62 * 256 * 4);
    const int b = unit >> 7, t0 = (unit & 127) * 32;
    for (int it = tid; it < 62 * 32; it += 512) {
        const int i = it >> 5, c8 = (it & 31) * 8, t = t0 - 30 + i;
        f32x4 h0 = (f32x4){0.f, 0.f, 0.f, 0.f}, h1 = h0;
        if (t >= 0) {
            const bf16_t* p = zm + ((size_t)b * SEQ + t) * ZM_LD + 1280 + c8;
            const u32x4 av = *(const u32x4*)p, gv = *(const u32x4*)(p + 256);
            h0 = (f32x4){bf_lo(av.x) * sigmoid_f(bf_lo(gv.x)), bf_hi(av.x) * sigmoid_f(bf_hi(gv.x)), bf_lo(av.y) * sigmoid_f(bf_lo(gv.y)), bf_hi(av.y) * sigmoid_f(bf_hi(gv.y))};
            h1 = (f32x4){bf_lo(av.z) * sigmoid_f(bf_lo(gv.z)), bf_hi(av.z) * sigmoid_f(bf_hi(gv.z)), bf_lo(av.w) * sigmoid_f(bf_lo(gv.w)), bf_hi(av.w) * sigmoid_f(bf_hi(gv.w))};
        }
        *(LAS f32x4*)(hbuf + i * 256 + c8) = h0; *(LAS f32x4*)(hbuf + i * 256 + c8 + 4) = h1;
    }
    __syncthreads();
    {
        const int c = tid & 255, th = tid >> 8;
        float w[31];
#pragma unroll
        for (int j = 0; j < 31; ++j) w[j] = cw[j * 256 + c];
        float acc[16]; const float bias = cb[c];
#pragma unroll
        for (int tt = 0; tt < 16; ++tt) acc[tt] = bias;
#pragma unroll
        for (int i = 0; i < 46; ++i) { const float hv = hbuf[(th * 16 + i) * 256 + c];
#pragma unroll
            for (int tt = 0; tt < 16; ++tt) { if (i - tt >= 0 && i - tt <= 30) acc[tt] += hv * w[i - tt]; } }
#pragma unroll
        for (int tt = 0; tt < 16; ++tt) obuf[(th * 16 + tt) * 256 + c] = acc[tt];
    }
    __syncthreads();
    {
        const f32x4 g4 = *(const f32x4*)(lg + 4 * lane), b4 = *(const f32x4*)(lb + 4 * lane);
#pragma unroll
        for (int k = 0; k < 4; ++k) { const int tok = wave * 4 + k;
            f32x4 v = *(const LAS f32x4*)(obuf + tok * 256 + 4 * lane);
            const float mean = wave_sum((v.x + v.y) + (v.z + v.w)) * (1.f / 256.f);
            v = v - mean;
            const float var = wave_sum((v.x * v.x + v.y * v.y) + (v.z * v.z + v.w * v.w)) * (1.f / 256.f);
            const float rstd = 1.f / sqrtf(var + LN_EPS);
            f32x4 y = v * rstd * g4 + b4;
#pragma unroll
            for (int e = 0; e < 4; ++e) y[e] = y[e] * sigmoid_f(y[e]);
            u32x2 wv; wv.x = cvt_pk_bf16(y.x, y.y); wv.y = cvt_pk_bf16(y.z, y.w);
            *(u32x2*)(bcat + ((size_t)b * SEQ + t0 + tok) * D + 768 + 4 * lane) = wv; }
    }
    __syncthreads();
}

__global__ void __launch_bounds__(512, 2) fwd(Args a) {
    extern __shared__ __attribute__((aligned(16))) unsigned char lds_raw[];
    LAS unsigned char* lds = (LAS unsigned char*)lds_raw;
    cg::grid_group grid = cg::this_grid();
    const int ph_lo = a.ph_lo, ph_hi = a.ph_hi;
    {
        if (threadIdx.x < 2) ((LAS unsigned*)(lds + 147456))[threadIdx.x] = 0u;
        if (blockIdx.x == 0) for (int i = threadIdx.x; i < XCD_BAR_WORDS; i += 512) ((unsigned*)(a.ws + WS_BAR))[i] = 0u;
        __syncthreads();
    }

#pragma clang loop unroll(full)
    for (int ph = 0; ph < NPH; ++ph) {
        if (ph < ph_lo || ph >= ph_hi) continue;
        const __attribute__((address_space(4))) Args* ap = (const __attribute__((address_space(4))) Args*)__builtin_amdgcn_kernarg_segment_ptr();
        asm volatile("" : "+s"(ap));
        int tid = threadIdx.x; asm volatile("" : "+v"(tid));
        const int lane = tid & 63, wave = __builtin_amdgcn_readfirstlane(tid >> 6);
        const int G = gridDim.x, bx = blockIdx.x;
        const int vcu = (G % 8 == 0) ? (bx % 8) * (G / 8) + bx / 8 : bx;
        const int gw = vcu * 8 + wave, ngw = G * 8;
#define AIN(k) (ap->in[k])
        unsigned char* ws = ap->ws;
        float* mod = (float*)(ws + WS_MOD);
        bf16_t* UB = (bf16_t*)(ws + WS_UB); bf16_t* ZM = (bf16_t*)(ws + WS_ZM); bf16_t* VT = (bf16_t*)(ws + WS_VT); bf16_t* ZG = (bf16_t*)(ws + WS_ZG);
        bf16_t* HB = (bf16_t*)(ws + WS_H); bf16_t* MG = (bf16_t*)(ws + WS_MG);
        float* outp = ap->out;
        if (ph > ph_lo) {
            XcdBarrier B; B.bar = (unsigned*)(ws + WS_BAR); B.x = xb_xcc_id(); B.st = (volatile LAS unsigned*)(lds + 147456);
            if (ph == ph_lo + 1) { grid.sync(); if (tid == 0) (void)xb_add(&B.bar[XB_XCNT(B.x)], 1u); }
            else xcd_barrier(B);
        }
        if (ph == 0) {
            LAS float* cact = (LAS float*)(lds + 98304);
            for (int i = tid; i < 8 * D; i += 512) { const float cv = AIN(I_C)[i]; cact[i] = cv * sigmoid_f(cv); }
            __syncthreads();
            LAS float* part = (LAS float*)(lds + 131072);
            for (int it = bx; it < 192; it += G) {
                const int l = it / 96, j = (it % 96) * 64 + lane;
                const float* W = AIN(I_WADA) + (size_t)l * D * 6144 + (size_t)(wave * 128) * 6144 + j;
                float acc[8];
#pragma unroll
                for (int b = 0; b < 8; ++b) acc[b] = 0.f;
                for (int k = 0; k < 128; k += 16) {
                    float wv[16];
#pragma unroll
                    for (int u = 0; u < 16; ++u) wv[u] = W[(size_t)(k + u) * 6144];
#pragma unroll
                    for (int b = 0; b < 8; ++b) {
#pragma unroll
                        for (int q = 0; q < 4; ++q) { const f32x4 c0 = *(const LAS f32x4*)(cact + b * D + wave * 128 + k + 4 * q);
                            acc[b] += (c0.x * wv[4 * q] + c0.y * wv[4 * q + 1]) + (c0.z * wv[4 * q + 2] + c0.w * wv[4 * q + 3]); } }
                }
#pragma unroll
                for (int b = 0; b < 8; ++b) part[(wave * 8 + b) * 64 + lane] = acc[b];
                __syncthreads();
                { float s = AIN(I_BADA)[l * 6144 + j];
#pragma unroll
                  for (int w = 0; w < 8; ++w) s += part[(w * 8 + wave) * 64 + lane];
                  mod[(size_t)(l * 8 + wave) * 6144 + j] = s; }
                __syncthreads();
            }
            LAS float* scr = (LAS float*)(lds + wave * 8704);
            constexpr int PER_L = 7680 + 128;
            for (int it = gw; it < DEPTH * PER_L; it += ngw) {
                const int l = it / PER_L; int r = it % PER_L;
                unsigned char* wl = ws + WS_W + (size_t)l * WS_WL;
                if (r < 2688) { const int k0 = (r / 168) * 64, n0 = (r % 168) * 32;
                    bf16_t* dst = (n0 >= 1280 && n0 < 1792) ? (bf16_t*)(wl + W_V) + (size_t)(n0 - 1280) * D + k0 : (bf16_t*)(wl + W_IN) + (size_t)(n0 >= 1792 ? n0 - 512 : n0) * D + k0;
                    tr_item(AIN(I_WIN) + (size_t)l * D * 5376, 5376, k0, n0, dst, D, scr, lane); continue; } r -= 2688;
                if (r < 256) { const int k0 = (r / 32) * 64, n0 = (r % 32) * 32; tr_item(AIN(I_WBA) + (size_t)l * 512 * D, D, k0, n0, (bf16_t*)(wl + W_BA) + (size_t)n0 * 512 + k0, 512, scr, lane); continue; } r -= 256;
                if (r < 128) { const int k0 = (r / 32) * 64, n0 = (r % 32) * 32; tr_item(AIN(I_WBC) + (size_t)l * 256 * D, D, k0, n0, (bf16_t*)(wl + W_BC) + (size_t)n0 * 256 + k0, 256, scr, lane); continue; } r -= 128;
                if (r < 512) { const int k0 = (r / 32) * 64, n0 = (r % 32) * 32; tr_item(AIN(I_WO) + (size_t)l * D * D, D, k0, n0, (bf16_t*)(wl + W_O) + (size_t)n0 * D + k0, D, scr, lane); continue; } r -= 512;
                if (r < 2048) { const int k0 = (r / 128) * 64, n0 = (r % 128) * 32; tr_item(AIN(I_W1) + (size_t)l * D * DFF, DFF, k0, n0, (bf16_t*)(wl + W_1) + (size_t)n0 * D + k0, D, scr, lane); continue; } r -= 2048;
                if (r < 2048) { const int k0 = (r / 32) * 64, n0 = (r % 32) * 32; tr_item(AIN(I_W2) + (size_t)l * DFF * D, D, k0, n0, (bf16_t*)(wl + W_2) + (size_t)n0 * DFF + k0, DFF, scr, lane); continue; } r -= 2048;
                {
                    const int g = r >> 5, n0 = (r & 31) * 32;
                    const float* ps = AIN(I_PSCALE) + l * 256 + g * 64; const float* wb = AIN(I_WBP) + (size_t)l * 256 * D + (size_t)(g * 64) * D + n0;
#pragma unroll 8
                    for (int i = 0; i < 32; ++i) { const int d = 2 * i + (lane >> 5), n = lane & 31; scr[n * 68 + d] = ps[d] * wb[(size_t)d * D + n]; }
                    LDS_WAIT();
                    f32x4 wpr[16]; const float* wp = AIN(I_WPOOL) + ((size_t)(l * 4 + g) * 64 + lane) * 64;
#pragma unroll
                    for (int q = 0; q < 16; ++q) wpr[q] = *(const f32x4*)(wp + 4 * q);
                    bf16_t* dst = (bf16_t*)(wl + W_BP) + (size_t)n0 * 256 + g * 64 + lane;
                    for (int n = 0; n < 32; ++n) { float acc = 0.f;
#pragma unroll
                        for (int q = 0; q < 16; ++q) { const f32x4 sv = *(const LAS f32x4*)(scr + n * 68 + 4 * q); acc += (wpr[q].x * sv.x + wpr[q].y * sv.y) + (wpr[q].z * sv.z + wpr[q].w * sv.w); }
                        dst[(size_t)n * 256] = (bf16_t)f2bf(acc); }
                    LDS_WAIT();
                }
            }
            __syncthreads();
        } else if (ph == 1) {
            ln_pass<0>(AIN(I_X), nullptr, UB, nullptr, nullptr, mod + 1 * D, mod + 0 * D, gw, ngw, lane);
        } else {
            const int l = (ph - 2) >> 3, sp = (ph - 2) & 7;
            unsigned char* wl = ws + WS_W + (size_t)l * WS_WL;
            const float* modl = mod + (size_t)l * 8 * 6144;
            if (sp == 0) {
                { pg8::Gemm g{UB, (const bf16_t*)(wl + W_IN), M, NWIN, D, D, D}; pg8::StaticOrder S; S.init(M, NWIN, G, bx);
                  pg8::EpiZ E{ZM, ZG, AIN(I_BGATE) + l * 3072};
                  pg8::gemm_phase(lds, tid, g, S, E); }
                { pg8::Gemm g{(const bf16_t*)(wl + W_V), UB, 512, M, D, D, D}; pg8::StaticOrder S; S.init(512, M, G, bx);
                  pg8::EpiBf16<0> E{VT, M, nullptr};
                  pg8::gemm_phase(lds, tid, g, S, E); }
            } else if (sp == 1) {
                LAS float* rbl = (LAS float*)lds;
                for (int i = tid; i < 8 * 257; i += 512) { const int h = i / 257, k = i % 257; rbl[h * 264 + k] = AIN(I_RELB)[(size_t)l * 8 * 257 + i] * LOG2E; }
                __syncthreads();
                for (int unit = vcu; unit < 512; unit += G) { const int b = unit >> 6, n = unit & 63;
                    attn_wave2(ZM, VT, UB, rbl + wave * 264, lds + 16384 + wave * 16384, b, n, wave, lane); }
                for (int it = gw; it < (M / 8) * 4; it += ngw) {
                    const int gi = it & 3, r = (it >> 2) * 8 + (lane >> 3), c0 = gi * 64 + (lane & 7) * 8;
                    if (gi == 0) pool_item<2>(ZM, UB, r, c0); else if (gi == 1) pool_item<4>(ZM, UB, r, c0); else if (gi == 2) pool_item<8>(ZM, UB, r, c0); else pool_item<16>(ZM, UB, r, c0);
                }
                __syncthreads();
                for (int unit = vcu; unit < 1024; unit += G)
                    conv_unit(lds, ZM, UB, AIN(I_CONVW) + l * 31 * 256, AIN(I_CONVB) + l * 256, AIN(I_CLNG) + l * 256, AIN(I_CLNB) + l * 256, unit, tid, wave, lane);
            } else if (sp == 2) {
                for (int br = 0; br < 3; ++br) {
                    const int K = br == 1 ? 512 : 256, aoff = br == 0 ? 0 : (br == 1 ? 256 : 768);
                    const bf16_t* Bt = (const bf16_t*)(wl + (br == 0 ? W_BP : (br == 1 ? W_BA : W_BC)));
                    pg8::Gemm g{UB + aoff, Bt, M, D, K, D, K}; pg8::StaticOrder S; S.init(M, D, G, bx);
                    pg8::EpiGate E{MG, ZG + br * D, br == 0};
                    pg8::gemm_phase(lds, tid, g, S, E);
                }
            } else if (sp == 3 || sp == 6) {
                const bool ff = (sp == 6);
                pg8::Gemm g{ff ? HB : MG, (const bf16_t*)(wl + (ff ? W_2 : W_O)), M, D, ff ? DFF : D, ff ? DFF : D, ff ? DFF : D}; pg8::StaticOrder S; S.init(M, D, G, bx);
                pg8::EpiRes E{(!ff && l == 0) ? AIN(I_X) : outp, outp, modl + (ff ? 5 : 2) * D, ff ? AIN(I_B2) + l * D : nullptr};
                pg8::gemm_phase(lds, tid, g, S, E);
            } else if (sp == 4) {
                ln_pass<1>(outp, outp, UB, AIN(I_LMG) + l * D, AIN(I_LMB) + l * D, modl + 4 * D, modl + 3 * D, gw, ngw, lane);
            } else if (sp == 5) {
                pg8::Gemm g{UB, (const bf16_t*)(wl + W_1), M, DFF, D, D, D}; pg8::StaticOrder S; S.init(M, DFF, G, bx);
                pg8::EpiBf16<1> E{HB, DFF, AIN(I_B1) + l * DFF};
                pg8::gemm_phase(lds, tid, g, S, E);
            } else {
                if (l + 1 < DEPTH) ln_pass<1>(outp, outp, UB, AIN(I_LFG) + l * D, AIN(I_LFB) + l * D, modl + 8 * 6144 + 1 * D, modl + 8 * 6144 + 0 * D, gw, ngw, lane);
                else ln_pass<2>(outp, outp, nullptr, AIN(I_LFG) + l * D, AIN(I_LFB) + l * D, nullptr, nullptr, gw, ngw, lane);
            }
        }
    }
}

extern "C" void kernel_launch(void* const* d_in, const int* in_sizes, int n_in, void* d_out, int out_size, void* d_ws, size_t ws_size, hipStream_t stream) {
    static int grid = 0;
    if (grid == 0) {
        if (n_in != 25 || in_sizes[0] != M * D || out_size != M * D || ws_size < WS_END) {
            fprintf(stderr, "kernel_launch: unexpected shapes: n_in %d in0 %d out %d ws %zu (need %zu); nothing launched\n", n_in, n_in > 0 ? in_sizes[0] : -1, out_size, ws_size, (size_t)WS_END); grid = -1; return; }
        int dev = 0, cus = 0, per_cu = 0;
        if (hipGetDevice(&dev) != hipSuccess || hipDeviceGetAttribute(&cus, hipDeviceAttributeMultiprocessorCount, dev) != hipSuccess) { grid = -1; return; }
        if (hipFuncSetAttribute((const void*)fwd, hipFuncAttributeMaxDynamicSharedMemorySize, LDS_BYTES) != hipSuccess) { fprintf(stderr, "kernel_launch: hipFuncSetAttribute failed\n"); grid = -1; return; }
        if (hipOccupancyMaxActiveBlocksPerMultiprocessor(&per_cu, (const void*)fwd, 512, LDS_BYTES) != hipSuccess || per_cu < 1) { fprintf(stderr, "kernel_launch: occupancy query says %d blocks per CU\n", per_cu); (void)hipGetLastError(); grid = -1; return; }
        grid = cus;
    }
    if (grid < 0) return;
    Args a{};
    for (int i = 0; i < 25; ++i) a.in[i] = (const float*)d_in[i];
    a.out = (float*)d_out; a.ws = (unsigned char*)d_ws;
#if MK_ONE_LAUNCH
    a.ph_lo = 0; a.ph_hi = NPH;
    void* args[] = {&a};
    hipError_t e = hipLaunchCooperativeKernel((const void*)fwd, dim3(grid), dim3(512), args, LDS_BYTES, stream);
    if (e != hipSuccess) fprintf(stderr, "cooperative launch failed: %s (grid %d)\n", hipGetErrorString(e), grid);
#else
    for (int ph = 0; ph < NPH; ++ph) { a.ph_lo = ph; a.ph_hi = ph + 1; hipLaunchKernelGGL(fwd, dim3(grid), dim3(512), LDS_BYTES, stream, a); }
#endif
}
```
